# Optimizing an MI355X kernel written in HIP

```python
import jax, jax.numpy as jnp
from jax import lax
import numpy as np

D_MODEL = 1024
BATCH = 8
SEQ = 4096
DEPTH = 4

N_ATTN_HEADS = 8
HEAD_DIM = 64
ATTN_WIDTH = N_ATTN_HEADS * HEAD_DIM
DILATED_PATTERNS = ((128, 1), (512, 4), (2048, 16))
SPAN = 128
MAX_DILATION = 16
PAD_MULT = MAX_DILATION * SPAN
LRU_WIDTH = D_MODEL // 2
N_LRU_BLOCKS = 8
LRU_BLOCK = LRU_WIDTH // N_LRU_BLOCKS
CONV_WIDTH = 4
LRU_C = 8.0
MIX_WIDTH = ATTN_WIDTH + LRU_WIDTH
IN_WIDTH = 3 * ATTN_WIDTH + 2 * LRU_WIDTH
D_FF = 4 * D_MODEL
NORM_EPS = 1e-6

kernel_name = "hybrid_dilated_attn_rglru_block"


def rms_norm(x, g):
    xf = x.astype(jnp.float32)
    y = xf * lax.rsqrt(jnp.mean(xf * xf, axis=-1, keepdims=True) + NORM_EPS)
    return (y * g.astype(jnp.float32)).astype(x.dtype)


def dilated_branch(q, k, v, window, dilation):
    b, sp, h, dh = q.shape
    span = window // dilation
    nb = sp // (dilation * span)

    def split(t):
        return t.reshape(b, nb, span, dilation, h, dh).transpose(0, 3, 4, 1, 2, 5)

    def with_prev(t):
        prev = jnp.pad(t, ((0, 0), (0, 0), (0, 0), (1, 0), (0, 0), (0, 0)))[:, :, :, :-1]
        return jnp.concatenate([prev, t], axis=4)

    qb = split(q)
    kb = with_prev(split(k))
    vb = with_prev(split(v))
    s = jnp.einsum('bchnqd,bchnkd->bchnqk', qb, kb,
                   preferred_element_type=jnp.float32) * (HEAD_DIM ** -0.5)
    qi = jnp.arange(span)[:, None]
    kj = jnp.arange(2 * span)[None, :]
    dist = span + qi - kj
    blk = jnp.arange(nb)[:, None, None]
    valid = (dist >= 0) & (dist <= span) & ((blk > 0) | (kj >= span))
    s = jnp.where(valid, s, -jnp.inf)
    mx = jnp.max(s, axis=-1, keepdims=True)
    p = jnp.exp(s - mx)
    den = jnp.sum(p, axis=-1)
    o = jnp.einsum('bchnqk,bchnkd->bchnqd', p, vb.astype(jnp.float32)) / den[..., None]
    lse = mx[..., 0] + jnp.log(den)
    o = o.transpose(0, 3, 4, 1, 2, 5).reshape(b, sp, h, dh)
    lse = lse.transpose(0, 3, 4, 1, 2).reshape(b, sp, h)
    return o, lse


def dilated_attention(q, k, v):
    b, s, h, dh = q.shape
    sp = -(-s // PAD_MULT) * PAD_MULT
    pad = ((0, 0), (0, sp - s), (0, 0), (0, 0))
    qp, kp, vp = jnp.pad(q, pad), jnp.pad(k, pad), jnp.pad(v, pad)
    outs, lses = [], []
    for window, dilation in DILATED_PATTERNS:
        o, l = dilated_branch(qp, kp, vp, window, dilation)
        outs.append(o)
        lses.append(l)
    wts = jax.nn.softmax(jnp.stack(lses, axis=0), axis=0)
    o = jnp.einsum('pbsh,pbshd->bshd', wts, jnp.stack(outs, axis=0))
    return o[:, :s].astype(q.dtype)


def causal_depthwise_conv(x, w, bias):
    c = x.shape[-1]
    y = lax.conv_general_dilated(x, w[:, None, :].astype(x.dtype), window_strides=(1,),
                                 padding=[(CONV_WIDTH - 1, 0)],
                                 dimension_numbers=('NWC', 'WIO', 'NWC'),
                                 feature_group_count=c)
    return y + bias.astype(x.dtype)


def rg_lru(x, w_r, b_r, w_i, b_i, lam):
    b, s, c = x.shape
    xf = x.astype(jnp.float32)
    xb = xf.reshape(b, s, N_LRU_BLOCKS, LRU_BLOCK)
    r = jax.nn.sigmoid(jnp.einsum('bsnc,ncd->bsnd', xb, w_r.astype(jnp.float32)).reshape(b, s, c)
                       + b_r.astype(jnp.float32))
    i = jax.nn.sigmoid(jnp.einsum('bsnc,ncd->bsnd', xb, w_i.astype(jnp.float32)).reshape(b, s, c)
                       + b_i.astype(jnp.float32))
    log_a = -LRU_C * r * jax.nn.softplus(-lam.astype(jnp.float32))
    a = jnp.exp(log_a)
    u = jnp.sqrt(-jnp.expm1(2.0 * log_a)) * (i * xf)

    def combine(left, right):
        a_l, h_l = left
        a_r, h_r = right
        return a_l * a_r, a_r * h_l + h_r

    _, h = lax.associative_scan(combine, (a, u), axis=1)
    return h.astype(x.dtype)


def hybrid_mixer(h, w_in, conv_w, conv_b, w_r, b_r, w_i, b_i, lam, w_out):
    b, s, _ = h.shape
    z = h @ w_in
    q, k, v, xr, gr = jnp.split(
        z, [ATTN_WIDTH, 2 * ATTN_WIDTH, 3 * ATTN_WIDTH, 3 * ATTN_WIDTH + LRU_WIDTH], axis=-1)
    shp = (b, s, N_ATTN_HEADS, HEAD_DIM)
    attn = dilated_attention(q.reshape(shp), k.reshape(shp), v.reshape(shp)).reshape(b, s, ATTN_WIDTH)
    xr = causal_depthwise_conv(xr, conv_w, conv_b)
    rec = rg_lru(xr, w_r, b_r, w_i, b_i, lam) * jax.nn.gelu(gr)
    return jnp.concatenate([attn.astype(h.dtype), rec.astype(h.dtype)], axis=-1) @ w_out


def squared_relu_mlp(h, w1, w2):
    a = jax.nn.relu(h @ w1)
    return (a * a) @ w2


def setup_inputs(seed: int = 0) -> dict:
    key = jax.random.key(seed)
    ks = jax.random.split(key, 20)
    f32 = jnp.float32

    def gain(k):
        return 1.0 + 0.05 * jax.random.normal(k, (DEPTH, D_MODEL), f32)

    u = jax.random.uniform(ks[10], (DEPTH, LRU_WIDTH), f32, 0.9, 0.999)
    a0 = u ** (1.0 / LRU_C)
    lru_lambda = jnp.log(a0) - jnp.log1p(-a0)
    return {
        "x": jax.random.normal(ks[0], (BATCH, SEQ, D_MODEL), f32),
        "mix_norm_pre": gain(ks[1]),
        "mix_norm_post": gain(ks[2]),
        "mlp_norm_pre": gain(ks[3]),
        "mlp_norm_post": gain(ks[4]),
        "w_in": jax.random.normal(ks[5], (DEPTH, D_MODEL, IN_WIDTH), f32) * D_MODEL ** -0.5,
        "conv_w": jax.random.normal(ks[6], (DEPTH, CONV_WIDTH, LRU_WIDTH), f32) * CONV_WIDTH ** -0.5,
        "conv_b": 0.01 * jax.random.normal(ks[7], (DEPTH, LRU_WIDTH), f32),
        "w_rgate": jax.random.normal(ks[8], (DEPTH, N_LRU_BLOCKS, LRU_BLOCK, LRU_BLOCK), f32) * LRU_BLOCK ** -0.5,
        "b_rgate": 0.01 * jax.random.normal(ks[9], (DEPTH, LRU_WIDTH), f32),
        "w_igate": jax.random.normal(ks[11], (DEPTH, N_LRU_BLOCKS, LRU_BLOCK, LRU_BLOCK), f32) * LRU_BLOCK ** -0.5,
        "b_igate": 0.01 * jax.random.normal(ks[12], (DEPTH, LRU_WIDTH), f32),
        "lru_lambda": lru_lambda,
        "w_out": jax.random.normal(ks[13], (DEPTH, MIX_WIDTH, D_MODEL), f32) * MIX_WIDTH ** -0.5,
        "w_ff_in": jax.random.normal(ks[14], (DEPTH, D_MODEL, D_FF), f32) * D_MODEL ** -0.5,
        "w_ff_out": jax.random.normal(ks[15], (DEPTH, D_FF, D_MODEL), f32) * D_FF ** -0.5,
    }


def reference(x, mix_norm_pre, mix_norm_post, mlp_norm_pre, mlp_norm_post, w_in, conv_w, conv_b,
              w_rgate, b_rgate, w_igate, b_igate, lru_lambda, w_out, w_ff_in, w_ff_out):
    for l in range(DEPTH):
        h = rms_norm(x, mix_norm_pre[l])
        m = hybrid_mixer(h, w_in[l], conv_w[l], conv_b[l], w_rgate[l], b_rgate[l],
                         w_igate[l], b_igate[l], lru_lambda[l], w_out[l])
        x = x + rms_norm(m, mix_norm_post[l])
        h = rms_norm(x, mlp_norm_pre[l])
        x = x + rms_norm(squared_relu_mlp(h, w_ff_in[l], w_ff_out[l]), mlp_norm_post[l])
    return x
```

```cpp
#include <hip/hip_runtime.h>
#include <hip/hip_cooperative_groups.h>
#include <cstdio>
#include <cstdint>
namespace cg = cooperative_groups;
namespace pg8 {
#define PG8_LAS __attribute__((address_space(3)))
typedef unsigned short bf16_t;
typedef short bf16x8 __attribute__((ext_vector_type(8)));
typedef float f32x4 __attribute__((ext_vector_type(4)));
typedef unsigned u32x4 __attribute__((ext_vector_type(4)));
constexpr int BM = 256, BK = 64, HALF = 128, HTB = HALF * BK * 2  , STAGE_BYTES = 8 * HTB, NXCD = 8, WGM = 8;

__host__ __device__ __forceinline__ int lds_byte(int r, int c) { const int st = (r >> 4) * 2 + (c >> 5), rr = r & 15, cc = c & 31, ob = rr * 64 + cc * 2; return st * 1024 + (ob ^ (((ob >> 9) & 1) << 5)); }
__host__ __device__ __forceinline__ void stage_rc(int b, int& R, int& C) { const int st = b / 1024, sb = b % 1024, swz = sb ^ (((sb >> 9) & 1) << 5); R = (st >> 1) * 16 + swz / 64; C = (st & 1) * 32 + (swz % 64) / 2; }
__host__ __device__ __forceinline__ int perm32(int rho) { const int n = rho >> 4, i = rho & 15; return 8 * (i >> 2) + 4 * n + (i & 3); }

struct Unit { int pm, pn; };
struct Gemm { const bf16_t* A; const bf16_t* Bt; int M, N, K; };

struct StaticOrder {
    int nM, nN, nwg, G, c;
    __host__ __device__ void init(int M, int N, int G_, int c_) { nM = M / BM; nN = N / BM; nwg = nM * nN; G = G_; c = c_; }
    __host__ __device__ bool next(int i, Unit& u) const {
        const long L = (long)i * G + c; if (L >= nwg) return false;
        int wgid = (int)L; { const int q = nwg / NXCD, r = nwg % NXCD, xcd = wgid % NXCD, off = wgid / NXCD; wgid = (xcd < r ? xcd * (q + 1) : r * (q + 1) + (xcd - r) * q) + off; }
        const int nig = WGM * nN, gid = wgid / nig, fm = gid * WGM, gsz = (nM - fm) < WGM ? (nM - fm) : WGM;
        u.pm = fm + ((wgid % nig) % gsz); u.pn = (wgid % nig) / gsz; return true;
    }
    __device__ __forceinline__ void a_ready(const Unit&) const {}
    __device__ __forceinline__ void done(const Unit&) const {}
};

__device__ __forceinline__ unsigned cvt_pk_bf16(float lo, float hi) { unsigned r; asm volatile("v_cvt_pk_bf16_f32 %0, %1, %2" : "=v"(r) : "v"(lo), "v"(hi)); return r; }
typedef float f32x2 __attribute__((ext_vector_type(2)));
__device__ __forceinline__ f32x2 gelu_pk(f32x2 v) {
    const f32x2 av = __builtin_elementwise_abs(v), d = av * 0.2316418882f + 1.0f;
    f32x2 t; t.x = __builtin_amdgcn_rcpf(d.x); t.y = __builtin_amdgcn_rcpf(d.y);
    f32x2 q = t * 0.5307027145f + (-0.7265760135f); q = q * t + 0.7107068705f; q = q * t + (-0.142248368f); q = q * t + 0.127414796f; q = q * t;
    const f32x2 s = (v * v) * (-0.72134752044f);
    f32x2 e; e.x = __builtin_amdgcn_exp2f(s.x); e.y = __builtin_amdgcn_exp2f(s.y);
    const f32x2 m = v * (q * e), r = v - m;
    f32x2 o; o.x = v.x < 0.f ? m.x : r.x; o.y = v.y < 0.f ? m.y : r.y; return o;
}

template <int ACT  > struct EpiBf16 {
    static constexpr bool PERM = true, AFTER_DRAIN = false; static_assert(ACT == 0 || ACT == 1 || ACT == 2, "EpiBf16: ACT is 0 (none), 1 (gelu_pk) or 2 (squared relu)");
    bf16_t* O; int ldc; const float* bias; int split_cols; size_t split_stride; float scale0; const float* rowscale; PG8_LAS unsigned char* xlds;
    __device__ __forceinline__ void operator()(const f32x4 (&acc)[2][2][4][2], const Unit& u, int wr, int wc, int fr, int fq) const {
        const int row0 = u.pm * BM + wr * 64 + fr; int colt = u.pn * BM; bf16_t* base = O;
        float sc = 1.f; if (split_cols) { const int t = colt / split_cols; base += (size_t)t * split_stride; colt -= t * split_cols; if (t == 0) sc = scale0; }
        const int col0 = colt + wc * 64 + 8 * fq, bcol0 = u.pn * BM + wc * 64 + 8 * fq;
        const int lane_ = fq * 16 + fr; PG8_LAS unsigned char* xw = xlds ? xlds + (wr * 4 + wc) * 2048 : xlds;
        float rs8[8];
#pragma unroll
        for (int i = 0; i < 8; ++i) rs8[i] = rowscale ? rowscale[row0 + (i >> 2) * HALF + (i & 3) * 16] : 1.f;
        f32x4 bv[2][2];
#pragma unroll
        for (int bj = 0; bj < 2; ++bj)
#pragma unroll
            for (int n = 0; n < 2; ++n) bv[bj][n] = bias ? *(const f32x4*)(bias + bcol0 + bj * 32 + 4 * n) : (f32x4){0.f, 0.f, 0.f, 0.f};
#pragma unroll
        for (int ai = 0; ai < 2; ++ai)
#pragma unroll
            for (int m = 0; m < 4; ++m) { bf16_t* rowp = base + (size_t)(row0 + ai * HALF + m * 16) * ldc + col0; const float rsv = rs8[ai * 4 + m];
#pragma unroll
                for (int bj = 0; bj < 2; ++bj) { f32x4 v0 = (acc[ai][bj][m][0] + bv[bj][0]) * rsv, v1 = (acc[ai][bj][m][1] + bv[bj][1]) * rsv;
                    if (ACT == 1) { f32x2 a = gelu_pk((f32x2){v0[0], v0[1]}), b = gelu_pk((f32x2){v0[2], v0[3]}), c = gelu_pk((f32x2){v1[0], v1[1]}), d = gelu_pk((f32x2){v1[2], v1[3]});
                        v0 = (f32x4){a.x, a.y, b.x, b.y}; v1 = (f32x4){c.x, c.y, d.x, d.y}; }
                    if (ACT == 2) { _Pragma("unroll") for (int e = 0; e < 4; ++e) { const float p0 = __builtin_fmaxf(v0[e], 0.f), p1 = __builtin_fmaxf(v1[e], 0.f); v0[e] = p0 * p0; v1[e] = p1 * p1; } }
                    v0 = v0 * sc; v1 = v1 * sc; u32x4 w; w.x = cvt_pk_bf16(v0[0], v0[1]); w.y = cvt_pk_bf16(v0[2], v0[3]); w.z = cvt_pk_bf16(v1[0], v1[1]); w.w = cvt_pk_bf16(v1[2], v1[3]);
                    if (xlds) *(PG8_LAS u32x4*)(xw + fr * 128 + (((bj * 4 + fq) ^ (fr & 7)) << 4)) = w;
                    else *(u32x4*)(rowp + bj * 32) = w; }
                if (xlds) { asm volatile("s_waitcnt lgkmcnt(0)" ::: "memory");
                    bf16_t* gp = base + (size_t)(u.pm * BM + wr * 64 + ai * HALF + m * 16) * ldc + colt + wc * 64;
#pragma unroll
                    for (int hh = 0; hh < 2; ++hh) { const int rr = (lane_ >> 3) + 8 * hh, ch = lane_ & 7;
                        const u32x4 t = *(const PG8_LAS u32x4*)(xw + rr * 128 + ((ch ^ (rr & 7)) << 4));
                        *(u32x4*)(gp + (size_t)rr * ldc + ch * 8) = t; }
                    asm volatile("s_waitcnt lgkmcnt(0)" ::: "memory"); } }
    }
};
template <class Epi, class Sched, bool ALIGN_EPI = false, bool SP2 = false>
__device__ __forceinline__ void gemm_phase(PG8_LAS unsigned char* lds, const Gemm g, const Sched& S, const Epi& E) {
    int tid_ = threadIdx.x; asm volatile("" : "+v"(tid_));
    const int tid = tid_, wid = __builtin_amdgcn_readfirstlane(tid >> 6), lane = tid & 63, wr = wid >> 2, wc = wid & 3, fr = lane & 15, fq = lane >> 4;
    const int K = g.K, nt = K / BK;
    unsigned voffA[2], voffB[2];
#pragma unroll
    for (int i = 0; i < 2; ++i) { int R, C; stage_rc(tid * 16 + i * 8192, R, C); const int Rb = Epi::PERM ? (64 * (R >> 5) + perm32(R & 31)) : R;
        voffA[i] = (unsigned)(R * K + C) * 2u; voffB[i] = (unsigned)(Rb * K + C) * 2u; }
    const size_t kstep = (size_t)(BK * 2);
    const size_t hstep = (size_t)HALF * K * 2;
    const size_t hstepB = Epi::PERM ? (size_t)32 * K * 2 : hstep;
    const size_t tstep = 2 * hstep;
    const unsigned ldsw = (unsigned)wid * 1024u;
    const int aoff = lds_byte(wr * 64 + fr, fq * 8), boff = lds_byte(wc * 32 + fr, fq * 8);
#define PG8_SA(b, h) (((b) * 2 + (h)) * HTB)
#define PG8_SB(b, h) ((4 + (b) * 2 + (h)) * HTB)
#define PG8_STAGE(bufoff, gbase, voff) do { _Pragma("unroll") for (int _i = 0; _i < 2; ++_i) \
        __builtin_amdgcn_global_load_lds((const unsigned*)((const char*)(gbase) + (voff)[_i]), (PG8_LAS unsigned*)(lds + (bufoff) + ldsw + _i * 8192), 16, 0, 0); } while (0)
#define PG8_LDA(dst, b, h) do { _Pragma("unroll") for (int m = 0; m < 4; ++m) _Pragma("unroll") for (int k = 0; k < 2; ++k) dst[m][k] = *(const PG8_LAS bf16x8*)(lds + PG8_SA(b, h) + aoff + m * 2048 + k * 1024); } while (0)
#define PG8_LDB(dst, b, h) do { _Pragma("unroll") for (int n = 0; n < 2; ++n) _Pragma("unroll") for (int k = 0; k < 2; ++k) dst[n][k] = *(const PG8_LAS bf16x8*)(lds + PG8_SB(b, h) + boff + n * 2048 + k * 1024); } while (0)
#define PG8_MMA(ai, bj, At, Bt) do { __builtin_amdgcn_s_setprio(1); _Pragma("unroll") for (int m = 0; m < 4; ++m) _Pragma("unroll") for (int n = 0; n < 2; ++n) _Pragma("unroll") for (int k = 0; k < 2; ++k) \
        acc[ai][bj][m][n] = __builtin_amdgcn_mfma_f32_16x16x32_bf16(Bt[n][k], At[m][k], acc[ai][bj][m][n], 0, 0, 0); __builtin_amdgcn_s_setprio(0); } while (0)
#define PG8_WAIT_V(n) asm volatile("s_waitcnt vmcnt(" #n ")" ::: "memory")
#define PG8_WAIT_L(n) asm volatile("s_waitcnt lgkmcnt(" #n ")" ::: "memory")
#define PG8_BAR __builtin_amdgcn_s_barrier()
#define PG8_SCHED __builtin_amdgcn_sched_barrier(0)
    Unit cur, nxt; int ui = 0;
    if (!S.next(0, cur)) return;
    f32x4 acc[2][2][4][2];
#pragma unroll
    for (int a = 0; a < 2; ++a)
#pragma unroll
        for (int b = 0; b < 2; ++b)
#pragma unroll
            for (int m = 0; m < 4; ++m)
#pragma unroll
                for (int n = 0; n < 2; ++n) acc[a][b][m][n] = (f32x4){0.f, 0.f, 0.f, 0.f};
    bf16x8 At[4][2], B0[2][2], B1[2][2];
    const char* cA = (const char*)g.A + (size_t)cur.pm * tstep; const char* cB = (const char*)g.Bt + (size_t)cur.pn * tstep;
    S.a_ready(cur);
    if constexpr (SP2) {
        PG8_STAGE(PG8_SB(0, 0), cB, voffB); PG8_STAGE(PG8_SB(0, 1), cB + hstepB, voffB); PG8_STAGE(PG8_SA(0, 0), cA, voffA); PG8_STAGE(PG8_SA(0, 1), cA + hstep, voffA);
        if (wr == 1) PG8_BAR;
        PG8_WAIT_V(2); PG8_BAR;
        PG8_STAGE(PG8_SB(1, 0), cB + kstep, voffB); PG8_STAGE(PG8_SA(1, 0), cA + kstep, voffA); PG8_STAGE(PG8_SB(1, 1), cB + hstepB + kstep, voffB);
        PG8_WAIT_V(6); PG8_BAR;
    } else {
        PG8_STAGE(PG8_SB(0, 0), cB, voffB); PG8_STAGE(PG8_SA(0, 0), cA, voffA); PG8_STAGE(PG8_SB(0, 1), cB + hstepB, voffB); PG8_STAGE(PG8_SA(0, 1), cA + hstep, voffA);
        if (wr == 1) PG8_BAR;
        PG8_WAIT_V(4); PG8_BAR;
        PG8_STAGE(PG8_SB(1, 0), cB + kstep, voffB); PG8_STAGE(PG8_SA(1, 0), cA + kstep, voffA); PG8_STAGE(PG8_SB(1, 1), cB + hstepB + kstep, voffB);
        PG8_WAIT_V(6); PG8_BAR;
    }
    for (;;) {
        const bool has_next = S.next(ui + 1, nxt);
        const char* nA = has_next ? (const char*)g.A + (size_t)nxt.pm * tstep : cA; const char* nB = has_next ? (const char*)g.Bt + (size_t)nxt.pn * tstep : cB;
        for (int t = 0; t < nt; t += 2) {
            const bool last = (t == nt - 2);
            const char* a1 = cA + (size_t)(t + 1) * kstep;
            const char* a2 = last ? nA : cA + (size_t)(t + 2) * kstep; const char* b2 = last ? nB : cB + (size_t)(t + 2) * kstep;
            const char* a3 = a2 + kstep; const char* b3 = b2 + kstep;
            if (last && has_next) S.a_ready(nxt);
            if constexpr (SP2) {
            PG8_LDB(B0, 0, 0); PG8_LDB(B1, 0, 1); PG8_SCHED; PG8_LDA(At, 0, 0); PG8_STAGE(PG8_SA(1, 1), a1 + hstep, voffA);
            PG8_WAIT_V(8); PG8_WAIT_L(0); PG8_BAR; PG8_MMA(0, 0, At, B0); PG8_MMA(0, 1, At, B1); PG8_BAR; PG8_SCHED;
            PG8_LDA(At, 0, 1); PG8_STAGE(PG8_SB(0, 0), b2, voffB); PG8_STAGE(PG8_SB(0, 1), b2 + hstepB, voffB); PG8_STAGE(PG8_SA(0, 0), a2, voffA);
            PG8_WAIT_V(8); PG8_WAIT_L(0); PG8_BAR; PG8_MMA(1, 0, At, B0); PG8_MMA(1, 1, At, B1); PG8_BAR; PG8_SCHED;
            PG8_LDB(B0, 1, 0); PG8_LDB(B1, 1, 1); PG8_SCHED; PG8_LDA(At, 1, 0); PG8_STAGE(PG8_SA(0, 1), a2 + hstep, voffA);
            PG8_WAIT_V(8); PG8_WAIT_L(0); PG8_BAR; PG8_MMA(0, 0, At, B0); PG8_MMA(0, 1, At, B1); PG8_BAR; PG8_SCHED;
            PG8_LDA(At, 1, 1); PG8_STAGE(PG8_SB(1, 0), b3, voffB); PG8_STAGE(PG8_SB(1, 1), b3 + hstepB, voffB); PG8_STAGE(PG8_SA(1, 0), a3, voffA);
            PG8_WAIT_V(8); PG8_WAIT_L(0); PG8_BAR; PG8_MMA(1, 0, At, B0); PG8_MMA(1, 1, At, B1); PG8_BAR; PG8_SCHED;
            } else {
            PG8_LDB(B0, 0, 0); PG8_SCHED; PG8_LDA(At, 0, 0); PG8_STAGE(PG8_SA(1, 1), a1 + hstep, voffA);
            PG8_WAIT_L(8); PG8_BAR; PG8_WAIT_L(0); PG8_MMA(0, 0, At, B0); PG8_BAR; PG8_SCHED;
            PG8_LDB(B1, 0, 1); PG8_STAGE(PG8_SB(0, 0), b2, voffB);
            PG8_BAR; PG8_WAIT_L(0); PG8_MMA(0, 1, At, B1); PG8_BAR;
            PG8_LDA(At, 0, 1); PG8_STAGE(PG8_SA(0, 0), a2, voffA);
            PG8_BAR; PG8_WAIT_L(0); PG8_MMA(1, 0, At, B0); PG8_BAR; PG8_SCHED;
            PG8_STAGE(PG8_SB(0, 1), b2 + hstepB, voffB);
            PG8_WAIT_V(6); PG8_BAR; PG8_MMA(1, 1, At, B1); PG8_BAR;
            PG8_LDB(B0, 1, 0); PG8_SCHED; PG8_LDA(At, 1, 0); PG8_STAGE(PG8_SA(0, 1), a2 + hstep, voffA);
            PG8_WAIT_L(8); PG8_BAR; PG8_WAIT_L(0); PG8_MMA(0, 0, At, B0); PG8_BAR; PG8_SCHED;
            PG8_LDB(B1, 1, 1); PG8_STAGE(PG8_SB(1, 0), b3, voffB);
            PG8_BAR; PG8_WAIT_L(0); PG8_MMA(0, 1, At, B1); PG8_BAR;
            PG8_LDA(At, 1, 1); PG8_STAGE(PG8_SA(1, 0), a3, voffA);
            PG8_BAR; PG8_WAIT_L(0); PG8_MMA(1, 0, At, B0); PG8_BAR; PG8_SCHED;
            PG8_STAGE(PG8_SB(1, 1), b3 + hstepB, voffB);
            PG8_WAIT_V(6); PG8_BAR; PG8_MMA(1, 1, At, B1); PG8_BAR;
            }
        }
        if constexpr (ALIGN_EPI) { if (wr == 0) PG8_BAR; }
        if constexpr (!Epi::AFTER_DRAIN) { E(acc, cur, wr, wc, fr, fq); S.done(cur); }
        if (!has_next) break;
#pragma unroll
        for (int a = 0; a < 2; ++a)
#pragma unroll
            for (int b = 0; b < 2; ++b)
#pragma unroll
                for (int m = 0; m < 4; ++m)
#pragma unroll
                    for (int n = 0; n < 2; ++n) acc[a][b][m][n] = (f32x4){0.f, 0.f, 0.f, 0.f};
        cur = nxt; cA = nA; cB = nB; ++ui;
        if constexpr (ALIGN_EPI) { if (wr == 1) PG8_BAR; }
    }
    PG8_WAIT_V(0);
    if constexpr (!ALIGN_EPI) { if (wr == 0) PG8_BAR; }
    PG8_BAR;
    if constexpr (Epi::AFTER_DRAIN) { E.fused(acc, cur, wr, wc, fr, fq, lds, wid, lane); S.done(cur); }
#undef PG8_SA
#undef PG8_SB
#undef PG8_STAGE
#undef PG8_LDA
#undef PG8_LDB
#undef PG8_MMA
#undef PG8_WAIT_V
#undef PG8_WAIT_L
#undef PG8_BAR
#undef PG8_SCHED
}
}

#ifndef PG8_SP2
#define PG8_SP2 true
#endif
#ifndef PG8_ALIGN
#define PG8_ALIGN true
#endif

constexpr int NB = 8, SEQ = 4096, DM = 1024, DEPTH = 4, NH = 8, HD = 64, AW = 512, LW = 512, INW = 2560, DFF = 4096;
constexpr int M = NB * SEQ;
constexpr float EPS = 1e-6f;
constexpr float QSCALE = 0.125f * 1.4426950408889634f;

constexpr size_t MiB = 1u << 20;
constexpr size_t WS_CTL = 0;
constexpr size_t WS_WIN = 1 * MiB, WS_WOUT = 21 * MiB, WS_WFF1 = 29 * MiB, WS_WFF2 = 61 * MiB;
constexpr size_t WS_H = 96 * MiB;
constexpr size_t WS_XR = 160 * MiB;
constexpr size_t WS_MB = 224 * MiB;
constexpr size_t WS_OP01 = 96 * MiB;
constexpr size_t WS_OP2 = 448 * MiB;
constexpr size_t WS_LSE = 480 * MiB;
constexpr size_t WS_Z = 224 * MiB;
constexpr size_t WS_MIX = 384 * MiB;
constexpr size_t WS_A = 224 * MiB;
constexpr size_t WS_RS1 = 484 * MiB;
constexpr size_t WS_RS2 = 484 * MiB + 262144;
constexpr size_t WS_FX1 = 485 * MiB, WS_FX2 = 485 * MiB + 524288;
constexpr size_t WS_END = 486 * MiB;
__device__ __forceinline__ unsigned short* op_base(unsigned char* ws, int p) { return (unsigned short*)(ws + (p == 2 ? WS_OP2 : WS_OP01 + (size_t)p * (32 * MiB))); }

constexpr int LDS_BYTES = 151552;
constexpr int XEPI_LDS_OFF = 133120;
constexpr int NWAVES = 8;

#define LAS __attribute__((address_space(3)))
typedef unsigned short bf16;
typedef short bf16x8 __attribute__((ext_vector_type(8)));
typedef short s16x4 __attribute__((ext_vector_type(4)));
typedef float f32x4 __attribute__((ext_vector_type(4)));
typedef unsigned u32x4 __attribute__((ext_vector_type(4)));
typedef unsigned u32x2 __attribute__((ext_vector_type(2)));

__device__ __forceinline__ unsigned f2bf(float f) { unsigned u = __builtin_bit_cast(unsigned, f); return (u + 0x7fffu + ((u >> 16) & 1u)) >> 16; }
typedef float f32x2_t __attribute__((ext_vector_type(2))); typedef __bf16 bf16x2_t __attribute__((ext_vector_type(2)));
__device__ __forceinline__ unsigned pk2(float lo, float hi) { f32x2_t v = {lo, hi}; bf16x2_t b = __builtin_convertvector(v, bf16x2_t); return __builtin_bit_cast(unsigned, b); }
__device__ __forceinline__ float bflo(unsigned w) { return __uint_as_float(w << 16); }
__device__ __forceinline__ float bfhi(unsigned w) { return __uint_as_float(w & 0xffff0000u); }
__device__ __forceinline__ float wave_sum(float v) {
#pragma unroll
    for (int o = 1; o < 64; o <<= 1) v += __shfl_xor(v, o);
    return v;
}

__device__ __forceinline__ void p0_transpose_item(const float* W, int K, int N, bf16* WT, LAS float* scr, int item, int lane, const float* gk) {
    const int nblk = N / 32, kb = item / nblk, nb = item % nblk, k0 = 64 * kb, n0 = 32 * nb;
    const int kl = lane >> 3, c4 = lane & 7;
    f32x4 v[8];
#pragma unroll
    for (int i = 0; i < 8; ++i) v[i] = *(const f32x4*)(W + (size_t)(k0 + 8 * i + kl) * N + n0 + 4 * c4);
#pragma unroll
    for (int i = 0; i < 8; ++i) { const float gv = gk ? gk[k0 + 8 * i + kl] : 1.f; LAS float* d = scr + (8 * i + kl) * 33 + 4 * c4; d[0] = v[i].x * gv; d[1] = v[i].y * gv; d[2] = v[i].z * gv; d[3] = v[i].w * gv; }
    asm volatile("s_waitcnt lgkmcnt(0)" ::: "memory");
    const int c = lane & 7;
#pragma unroll
    for (int j = 0; j < 4; ++j) { const int n = (lane >> 3) + 8 * j; const LAS float* s = scr + (8 * c) * 33 + n;
        u32x4 o; o.x = pk2(s[0 * 33], s[1 * 33]); o.y = pk2(s[2 * 33], s[3 * 33]); o.z = pk2(s[4 * 33], s[5 * 33]); o.w = pk2(s[6 * 33], s[7 * 33]);
        *(u32x4*)(WT + (size_t)(n0 + n) * K + k0 + 8 * c) = o; }
    asm volatile("s_waitcnt lgkmcnt(0)" ::: "memory");
}

template <int R> __device__ __forceinline__ void rms_rows_to_bf16(const float* x, float* rsout, bf16* out, int m0, int mstride, int lane) {
    f32x4 v[R][4]; float s[R];
#pragma unroll
    for (int r = 0; r < R; ++r)
#pragma unroll
        for (int j = 0; j < 4; ++j) v[r][j] = *((const f32x4*)(x + (size_t)(m0 + r * mstride) * DM) + lane + 64 * j);
#pragma unroll
    for (int r = 0; r < R; ++r) { float a = 0.f;
#pragma unroll
        for (int j = 0; j < 4; ++j) a += (v[r][j].x * v[r][j].x + v[r][j].y * v[r][j].y) + (v[r][j].z * v[r][j].z + v[r][j].w * v[r][j].w);
        s[r] = a; }
#pragma unroll
    for (int o = 1; o < 64; o <<= 1)
#pragma unroll
        for (int r = 0; r < R; ++r) s[r] += __shfl_xor(s[r], o);
#pragma unroll
    for (int r = 0; r < R; ++r) { if (lane == 0) rsout[m0 + r * mstride] = __builtin_amdgcn_rsqf(s[r] * (1.f / DM) + EPS);
        u32x2* o8 = (u32x2*)(out + (size_t)(m0 + r * mstride) * DM) + lane;
#pragma unroll
        for (int j = 0; j < 4; ++j) { u32x2 w; w.x = pk2(v[r][j].x, v[r][j].y); w.y = pk2(v[r][j].z, v[r][j].w); o8[64 * j] = w; } }
}

template <int R, bool XIN32, bool XOUT32> __device__ __forceinline__ void post_norm_rows(const bf16* mb, const void* xin, void* xout, const float* gpost, float* rsout, int m0, int mstride, int lane) {
    f32x4 xv[R][4]; u32x2 mw[R][4]; float s[R];
#pragma unroll
    for (int r = 0; r < R; ++r)
#pragma unroll
        for (int j = 0; j < 4; ++j) { const size_t ro = (size_t)(m0 + r * mstride) * DM; mw[r][j] = *((const u32x2*)(mb + ro) + lane + 64 * j);
            if (XIN32) xv[r][j] = *((const f32x4*)((const float*)xin + ro) + lane + 64 * j);
            else { const u32x2 w = *((const u32x2*)((const bf16*)xin + ro) + lane + 64 * j); xv[r][j] = (f32x4){bflo(w.x), bfhi(w.x), bflo(w.y), bfhi(w.y)}; } }
    f32x4 gg[4];
#pragma unroll
    for (int j = 0; j < 4; ++j) gg[j] = *((const f32x4*)gpost + lane + 64 * j);
#pragma unroll
    for (int r = 0; r < R; ++r) { float a = 0.f;
#pragma unroll
        for (int j = 0; j < 4; ++j) { const float a0 = bflo(mw[r][j].x), a1 = bfhi(mw[r][j].x), a2 = bflo(mw[r][j].y), a3 = bfhi(mw[r][j].y); a += (a0 * a0 + a1 * a1) + (a2 * a2 + a3 * a3); }
        s[r] = a; }
#pragma unroll
    for (int o = 1; o < 64; o <<= 1)
#pragma unroll
        for (int r = 0; r < R; ++r) s[r] += __shfl_xor(s[r], o);
#pragma unroll
    for (int r = 0; r < R; ++r) { const float rs = __builtin_amdgcn_rsqf(s[r] * (1.f / DM) + EPS); float a = 0.f; const size_t ro = (size_t)(m0 + r * mstride) * DM;
#pragma unroll
        for (int j = 0; j < 4; ++j) { const f32x4 mv = {bflo(mw[r][j].x), bfhi(mw[r][j].x), bflo(mw[r][j].y), bfhi(mw[r][j].y)};
            xv[r][j] = xv[r][j] + mv * rs * gg[j];
            if (XOUT32) *((f32x4*)((float*)xout + ro) + lane + 64 * j) = xv[r][j];
            else { u32x2 w; w.x = pk2(xv[r][j].x, xv[r][j].y); w.y = pk2(xv[r][j].z, xv[r][j].w); *((u32x2*)((bf16*)xout + ro) + lane + 64 * j) = w; }
            a += (xv[r][j].x * xv[r][j].x + xv[r][j].y * xv[r][j].y) + (xv[r][j].z * xv[r][j].z + xv[r][j].w * xv[r][j].w); }
        s[r] = a; }
    if (rsout) {
#pragma unroll
        for (int o = 1; o < 64; o <<= 1)
#pragma unroll
            for (int r = 0; r < R; ++r) s[r] += __shfl_xor(s[r], o);
#pragma unroll
        for (int r = 0; r < R; ++r) if (lane == 0) rsout[m0 + r * mstride] = __builtin_amdgcn_rsqf(s[r] * (1.f / DM) + EPS);
    }
}

constexpr int LRU_LDS_OFF = 98304;
constexpr int XB_LDS_OFF = 132096;
__device__ __forceinline__ float sigmoidf_(float x) { return __builtin_amdgcn_rcpf(1.0f + __builtin_amdgcn_exp2f(-1.4426950408889634f * x)); }
__device__ __forceinline__ float gelu_tanh(float g) { const float y2 = (2.0f * 0.7978845608028654f) * (g + 0.044715f * g * g * g); return g * sigmoidf_(y2); }

__device__ __forceinline__ void lru_unit(int unit, const bf16* Z, bf16* MIX, const float* conv_w, const float* conv_b, const float* w_r, const float* b_r,
                                         const float* w_i, const float* b_i, const float* lam, LAS unsigned char* lds) {
    const int qt = unit & 3, n = (unit >> 2) & 7, b = unit >> 5;
    int tid_ = threadIdx.x; asm volatile("" : "+v"(tid_));
    const int tid = tid_, lane = tid & 63, wid = __builtin_amdgcn_readfirstlane(tid >> 6), l15 = lane & 15, fq = lane >> 4;
    bf16x8 wd[4][2]; f32x4 cbv[4];
    bf16x8 wr[2], wi[2], wx[2];
#pragma unroll
    for (int ct = 0; ct < 4; ++ct) {
#pragma unroll
        for (int r = 0; r < 4; ++r) cbv[ct][r] = conv_b[64 * n + 16 * ct + 4 * fq + r];
#pragma unroll
        for (int ksp = 0; ksp < 2; ++ksp)
#pragma unroll
            for (int j = 0; j < 8; ++j) { const int tap = 2 * ksp + (fq >> 1), chl = 8 * (fq & 1) + j;
                wd[ct][ksp][j] = (chl == l15) ? (short)f2bf(conv_w[tap * LW + 64 * n + 16 * ct + chl]) : (short)0; }
    }
#pragma unroll
    for (int ks = 0; ks < 2; ++ks)
#pragma unroll
        for (int j = 0; j < 8; ++j) { const int sig = 16 * (2 * ks + (j >> 2)) + 4 * fq + (j & 3);
            wr[ks][j] = (short)f2bf(w_r[(size_t)(n * 64 + sig) * 64 + 16 * qt + l15]);
            wi[ks][j] = (short)f2bf(w_i[(size_t)(n * 64 + sig) * 64 + 16 * qt + l15]);
            wx[ks][j] = (sig == 16 * qt + l15) ? (short)0x3F80 : (short)0; }
    const int chan = 64 * n + 16 * qt + l15;
    const float br = b_r[chan], bi = b_i[chan], sp8 = -8.0f * log1pf(__expf(-lam[chan]));
    const bf16* Zb = Z + (size_t)b * SEQ * INW;
    bf16* Ob = MIX + (size_t)b * SEQ * DM + AW + chan;
    float hseg = 0.f;
    const bf16* Zx = Zb + 1536 + 64 * n + 8 * (fq & 1);
#define LRU_LOAD(dst, tbase) do { _Pragma("unroll") for (int ksp_ = 0; ksp_ < 2; ++ksp_) { int tt_ = (tbase) + l15 - 3 + 2 * ksp_ + (fq >> 1); tt_ = tt_ < 0 ? 0 : (tt_ > SEQ - 1 ? SEQ - 1 : tt_); \
        _Pragma("unroll") for (int ct_ = 0; ct_ < 4; ++ct_) dst[ct_][ksp_] = *(const u32x4*)(Zx + (size_t)tt_ * INW + 16 * ct_); } } while (0)
    u32x4 bufA[4][2], bufB[4][2];
    unsigned short grn[4][4];
    LRU_LOAD(bufA, wid * 64); LRU_LOAD(bufB, wid * 64 + 16);
#pragma unroll
    for (int mt = 0; mt < 4; ++mt)
#pragma unroll
        for (int r = 0; r < 4; ++r) grn[mt][r] = Zb[(size_t)(wid * 64 + 16 * mt + 4 * fq + r) * INW + 2048 + chan];
    for (int seg = 0; seg < 8; ++seg) {
        const int tw = seg * 512 + wid * 64;
        float Cel[4][4], Hel[4][4];
        unsigned short grv[4][4];
#pragma unroll
        for (int mt = 0; mt < 4; ++mt)
#pragma unroll
            for (int r = 0; r < 4; ++r) { grv[mt][r] = grn[mt][r]; const int tn = tw + 512 + 16 * mt + 4 * fq + r; grn[mt][r] = Zb[(size_t)(tn > SEQ - 1 ? SEQ - 1 : tn) * INW + 2048 + chan]; }
        float Cw = 1.f, Hw = 0.f;
#pragma unroll
        for (int mt = 0; mt < 4; ++mt) {
            const int t = tw + 16 * mt + l15;
            f32x4 accr = {0.f, 0.f, 0.f, 0.f}, acci = {0.f, 0.f, 0.f, 0.f}, accx = {0.f, 0.f, 0.f, 0.f};
            f32x4 cacc[4];
#pragma unroll
            for (int ct = 0; ct < 4; ++ct) {
                cacc[ct] = cbv[ct];
#pragma unroll
                for (int ksp = 0; ksp < 2; ++ksp) {
                    u32x4 v = (mt & 1) ? bufB[ct][ksp] : bufA[ct][ksp];
                    if ((tw + 16 * mt) == 0) { if (t - 3 + 2 * ksp + (fq >> 1) < 0) v = (u32x4){0u, 0u, 0u, 0u}; }
                    cacc[ct] = __builtin_amdgcn_mfma_f32_16x16x32_bf16(wd[ct][ksp], __builtin_bit_cast(bf16x8, v), cacc[ct], 0, 0, 0);
                }
            }
            { const int tb = (mt < 2) ? tw + 16 * (mt + 2) : tw + 512 + 16 * (mt - 2); if (mt & 1) LRU_LOAD(bufB, tb); else LRU_LOAD(bufA, tb); }
#pragma unroll
            for (int ks = 0; ks < 2; ++ks) {
                u32x4 ap; ap.x = pk2(cacc[2 * ks][0], cacc[2 * ks][1]); ap.y = pk2(cacc[2 * ks][2], cacc[2 * ks][3]);
                ap.z = pk2(cacc[2 * ks + 1][0], cacc[2 * ks + 1][1]); ap.w = pk2(cacc[2 * ks + 1][2], cacc[2 * ks + 1][3]);
                const bf16x8 a = __builtin_bit_cast(bf16x8, ap);
                accr = __builtin_amdgcn_mfma_f32_16x16x32_bf16(a, wr[ks], accr, 0, 0, 0);
                acci = __builtin_amdgcn_mfma_f32_16x16x32_bf16(a, wi[ks], acci, 0, 0, 0);
                accx = __builtin_amdgcn_mfma_f32_16x16x32_bf16(a, wx[ks], accx, 0, 0, 0);
            }
            float C[4], H[4];
#pragma unroll
            for (int r = 0; r < 4; ++r) {
                const float rg = sigmoidf_(accr[r] + br), ig = sigmoidf_(acci[r] + bi);
                const float la = sp8 * rg; const float a_ = __builtin_amdgcn_exp2f(1.4426950408889634f * la); const float mult = __builtin_amdgcn_sqrtf(fmaxf(1.0f - a_ * a_, 0.f));
                const float u_ = mult * ig * accx[r];
                if (r == 0) { C[0] = a_; H[0] = u_; } else { C[r] = a_ * C[r - 1]; H[r] = a_ * H[r - 1] + u_; }
            }
            float Ct = C[3], Ht = H[3];
            { const float Cp = __shfl_up(Ct, 16), Hp = __shfl_up(Ht, 16); if (fq >= 1) { Ht = Ct * Hp + Ht; Ct = Ct * Cp; } }
            { const float Cp = __shfl_up(Ct, 32), Hp = __shfl_up(Ht, 32); if (fq >= 2) { Ht = Ct * Hp + Ht; Ct = Ct * Cp; } }
            float Ce = __shfl_up(Ct, 16), He = __shfl_up(Ht, 16); if (fq == 0) { Ce = 1.f; He = 0.f; }
            const float Ctile = __shfl(Ct, 48 + l15), Htile = __shfl(Ht, 48 + l15);
            const float Cp = Cw * Ce, Hp = Ce * Hw + He;
#pragma unroll
            for (int r = 0; r < 4; ++r) { Cel[mt][r] = Cp * C[r]; Hel[mt][r] = C[r] * Hp + H[r]; }
            Hw = Ctile * Hw + Htile; Cw = Cw * Ctile;
        }
        LAS float* tot = (LAS float*)(lds + LRU_LDS_OFF) + (seg & 1) * 256;
        if (fq == 0) { tot[(wid * 16 + l15) * 2] = Cw; tot[(wid * 16 + l15) * 2 + 1] = Hw; }
        __syncthreads();
        float hin = hseg, hall = hseg;
#pragma unroll
        for (int w2 = 0; w2 < 8; ++w2) { const float c2 = tot[(w2 * 16 + l15) * 2], h2 = tot[(w2 * 16 + l15) * 2 + 1]; hall = c2 * hall + h2; if (w2 < wid) hin = hall; }
#pragma unroll
        for (int mt = 0; mt < 4; ++mt)
#pragma unroll
            for (int r = 0; r < 4; ++r) {
                const float hv = Cel[mt][r] * hin + Hel[mt][r];
                const float g = __uint_as_float((unsigned)grv[mt][r] << 16);
                Ob[(size_t)(tw + 16 * mt + 4 * fq + r) * DM] = (bf16)f2bf(hv * gelu_tanh(g));
            }
        hseg = hall;
    }
#undef LRU_LOAD
    __syncthreads();
}

constexpr int AT_PITCH = 160;
constexpr int AT_K = 0, AT_V = 384 * AT_PITCH;
constexpr int ATT_UNITS = NB * NH * 3 * 16;

struct AttPre { u32x4 k[6], v[6], q[4]; };
__device__ __forceinline__ void att_decode(int u, int& b, int& h, int& br, int& dsh, int& c, int& n2) {
    const int blk = u & 15, t = u >> 4; br = t % 3; const int bh = t / 3; h = bh & 7; b = bh >> 3; dsh = 2 * br; c = blk >> (4 - dsh); n2 = blk & ((16 >> dsh) - 1);
}
__device__ __forceinline__ void att_issue(int u, const bf16* Z, AttPre& P) {
    int b, h, br, dsh, c, n2; att_decode(u, b, h, br, dsh, c, n2);
    int tid_ = threadIdx.x; asm volatile("" : "+v"(tid_));
    const int tid = tid_, lane = tid & 63, wid = tid >> 6, l15 = lane & 15, fq = lane >> 4;
    const bf16* Zb = Z + (size_t)b * SEQ * INW + h * HD;
#pragma unroll
    for (int i = 0; i < 6; ++i) {
        const int id = tid + 512 * i, row = id >> 3, ch = id & 7; int tau = n2 * 256 - 128 + row; tau = tau < 0 ? 0 : tau;
        const bf16* p = Zb + (size_t)((tau << dsh) + c) * INW + ch * 8;
        P.k[i] = *(const u32x4*)(p + AW); P.v[i] = *(const u32x4*)(p + 2 * AW);
    }
#pragma unroll
    for (int blk = 0; blk < 2; ++blk) {
        const int posq = ((n2 * 256 + 128 * blk + 16 * wid + l15) << dsh) + c;
#pragma unroll
        for (int ks = 0; ks < 2; ++ks) P.q[2 * blk + ks] = *(const u32x4*)(Zb + (size_t)posq * INW + 32 * ks + 8 * fq);
    }
}
__device__ __forceinline__ void att_stage(const AttPre& P, LAS unsigned char* lds) {
    int tid_ = threadIdx.x; asm volatile("" : "+v"(tid_)); const int tid = tid_;
#pragma unroll
    for (int i = 0; i < 6; ++i) { const int id = tid + 512 * i, row = id >> 3, ch = id & 7;
        *(LAS u32x4*)(lds + AT_K + row * AT_PITCH + ch * 16) = P.k[i]; *(LAS u32x4*)(lds + AT_V + row * AT_PITCH + ch * 16) = P.v[i]; }
}
__device__ __forceinline__ s16x4 vtr(const LAS unsigned char* p) { return __builtin_bit_cast(s16x4, __builtin_amdgcn_ds_read_tr16_b64_v4i16((LAS s16x4*)p)); }

__device__ __forceinline__ void att_compute(int u, int blk, const u32x4& qf0, const u32x4& qf1, unsigned char* ws, float* LSE, LAS unsigned char* lds) {
    int b, h, br, dsh, c, n2; att_decode(u, b, h, br, dsh, c, n2); const int n = 2 * n2 + blk;
    int tid_ = threadIdx.x; asm volatile("" : "+v"(tid_));
    const int tid = tid_, lane = tid & 63, wid = __builtin_amdgcn_readfirstlane(tid >> 6), l15 = lane & 15, fq = lane >> 4;
    const bf16x8 q0 = __builtin_bit_cast(bf16x8, qf0), q1 = __builtin_bit_cast(bf16x8, qf1);
    f32x4 s[9];
    const LAS unsigned char* kb = lds + AT_K + (128 * blk + 16 * wid + l15) * AT_PITCH + fq * 16;
#pragma unroll
    for (int j = 0; j < 9; ++j) {
        const bf16x8 a0 = *(const LAS bf16x8*)(kb + j * 16 * AT_PITCH), a1 = *(const LAS bf16x8*)(kb + j * 16 * AT_PITCH + 64);
        f32x4 acc = {0.f, 0.f, 0.f, 0.f};
        acc = __builtin_amdgcn_mfma_f32_16x16x32_bf16(a0, q0, acc, 0, 0, 0);
        acc = __builtin_amdgcn_mfma_f32_16x16x32_bf16(a1, q1, acc, 0, 0, 0);
        s[j] = acc;
    }
    const float NEG = -INFINITY;
#pragma unroll
    for (int r = 0; r < 4; ++r) { const int dlt = 4 * fq + r - l15; if (dlt < 0) s[0][r] = NEG; if (dlt > 0) s[8][r] = NEG; }
    if (n == 0) {
#pragma unroll
        for (int j = 0; j < 8; ++j) if (wid + j < 8) s[j] = (f32x4){NEG, NEG, NEG, NEG};
    }
    float m = NEG;
#pragma unroll
    for (int j = 0; j < 9; ++j) m = fmaxf(m, fmaxf(fmaxf(s[j][0], s[j][1]), fmaxf(s[j][2], s[j][3])));
    m = fmaxf(m, __shfl_xor(m, 16)); m = fmaxf(m, __shfl_xor(m, 32));
    float l = 0.f;
#pragma unroll
    for (int j = 0; j < 9; ++j)
#pragma unroll
        for (int r = 0; r < 4; ++r) { const float p = __builtin_amdgcn_exp2f(s[j][r] - m); s[j][r] = p; l += p; }
    l += __shfl_xor(l, 16); l += __shfl_xor(l, 32);
    bf16x8 pb[5];
#pragma unroll
    for (int pr = 0; pr < 5; ++pr) {
        u32x4 w; w.x = pk2(s[2 * pr][0], s[2 * pr][1]); w.y = pk2(s[2 * pr][2], s[2 * pr][3]);
        if (pr < 4) { w.z = pk2(s[2 * pr + 1][0], s[2 * pr + 1][1]); w.w = pk2(s[2 * pr + 1][2], s[2 * pr + 1][3]); } else { w.z = 0u; w.w = 0u; }
        pb[pr] = __builtin_bit_cast(bf16x8, w);
    }
    const LAS unsigned char* vb = lds + AT_V + (128 * blk + 16 * wid + 4 * fq + (l15 >> 2)) * AT_PITCH + (l15 & 3) * 8;
    f32x4 o[4];
#pragma unroll
    for (int dt = 0; dt < 4; ++dt) {
        f32x4 acc = {0.f, 0.f, 0.f, 0.f};
#pragma unroll
        for (int pr = 0; pr < 5; ++pr) {
            const s16x4 lo = vtr(vb + (2 * pr) * 16 * AT_PITCH + dt * 32);
            s16x4 hi = {0, 0, 0, 0};
            if (pr < 4) hi = vtr(vb + (2 * pr + 1) * 16 * AT_PITCH + dt * 32);
            const bf16x8 a = {lo[0], lo[1], lo[2], lo[3], hi[0], hi[1], hi[2], hi[3]};
            acc = __builtin_amdgcn_mfma_f32_16x16x32_bf16(a, pb[pr], acc, 0, 0, 0);
        }
        o[dt] = acc;
    }
    const float inv = __builtin_amdgcn_rcpf(l);
    const int posq = ((n * 128 + 16 * wid + l15) << dsh) + c;
    const size_t row = (size_t)b * SEQ + posq;
    bf16* op = op_base(ws, br) + row * AW + h * HD + 4 * fq;
#pragma unroll
    for (int dt = 0; dt < 4; ++dt) { u32x2 w; w.x = pk2(o[dt][0] * inv, o[dt][1] * inv); w.y = pk2(o[dt][2] * inv, o[dt][3] * inv); *(u32x2*)(op + 16 * dt) = w; }
    if (fq == 0) LSE[((size_t)br * M + row) * NH + h] = m + __builtin_amdgcn_logf(l);
}

__device__ __forceinline__ void att_combine(unsigned char* ws, const float* LSE, bf16* MIX, int gtid, int gthreads) {
    for (int id = gtid; id < M * 64; id += gthreads) {
        const int row = id >> 6, ch = id & 63, h = ch >> 3;
        float L[3];
#pragma unroll
        for (int p = 0; p < 3; ++p) L[p] = LSE[((size_t)p * M + row) * NH + h];
        const float mx = fmaxf(L[0], fmaxf(L[1], L[2]));
        float w[3]; float sw = 0.f;
#pragma unroll
        for (int p = 0; p < 3; ++p) { w[p] = __builtin_amdgcn_exp2f(L[p] - mx); sw += w[p]; }
        const float isw = __builtin_amdgcn_rcpf(sw);
        float acc[8] = {0.f, 0.f, 0.f, 0.f, 0.f, 0.f, 0.f, 0.f};
#pragma unroll
        for (int p = 0; p < 3; ++p) { const u32x4 v = *(const u32x4*)(op_base(ws, p) + (size_t)row * AW + ch * 8); const float ww = w[p] * isw;
            acc[0] += ww * bflo(v.x); acc[1] += ww * bfhi(v.x); acc[2] += ww * bflo(v.y); acc[3] += ww * bfhi(v.y);
            acc[4] += ww * bflo(v.z); acc[5] += ww * bfhi(v.z); acc[6] += ww * bflo(v.w); acc[7] += ww * bfhi(v.w); }
        u32x4 o; o.x = pk2(acc[0], acc[1]); o.y = pk2(acc[2], acc[3]); o.z = pk2(acc[4], acc[5]); o.w = pk2(acc[6], acc[7]);
        *(u32x4*)(MIX + (size_t)row * DM + ch * 8) = o;
    }
}

#define XB_TMO      128
#define XB_XCNT(j)  (256  + 64 * (j))
#define XB_XSUB(j)  (1280 + 64 * (j))
#define XB_XGEN(j)  (2304 + 64 * (j))
#define XB_TOP      3328
#define XB_TOPGEN   3392
#define XCD_BAR_WORDS 3456
#define XB_SPIN_CAP (1u << 18)

__device__ __forceinline__ unsigned xb_ld(unsigned* p)              { return __hip_atomic_load(p, __ATOMIC_RELAXED, __HIP_MEMORY_SCOPE_AGENT); }
__device__ __forceinline__ unsigned xb_add(unsigned* p, unsigned v) { return __hip_atomic_fetch_add(p, v, __ATOMIC_RELAXED, __HIP_MEMORY_SCOPE_AGENT); }
__device__ __forceinline__ unsigned xb_xcc_id() { return (unsigned)__builtin_amdgcn_s_getreg((3 << 11) | 20) & 0xFu; }
#define XB_SPIN(cond, bar) do { unsigned _sp = 0; while (cond) { __builtin_amdgcn_s_sleep(1); \
    if ((++_sp & 255u) == 0u) { if (xb_ld(&(bar)[XB_TMO])) break; if (_sp > XB_SPIN_CAP) { atomicAdd(&(bar)[XB_TMO], 1u); break; } } } } while (0)

struct XcdBarrier {
    unsigned* bar; unsigned x;
    volatile LAS unsigned* st;
};

__device__ __forceinline__ XcdBarrier xcd_barrier_post(unsigned* bar, volatile LAS unsigned* st) {
    XcdBarrier b; b.bar = bar; b.x = xb_xcc_id(); b.st = st;
    if (threadIdx.x == 0) (void)xb_add(&bar[XB_XCNT(b.x)], 1u);
    return b;
}
__device__ __forceinline__ void xcd_barrier_complete(unsigned* bar, unsigned x, unsigned& nloc, unsigned& nx) {
    const unsigned G = gridDim.x * gridDim.y * gridDim.z;
    unsigned sum, cnt, mine, sp = 0u;
    for (;;) {
        sum = 0u; cnt = 0u; mine = 0u;
#pragma unroll
        for (unsigned j = 0; j < 16; ++j) { const unsigned c = xb_ld(&bar[XB_XCNT(j)]); sum += c; cnt += (c > 0u) ? 1u : 0u; mine = (j == x) ? c : mine; }
        if (sum == G) break;
        __builtin_amdgcn_s_sleep(1);
        if ((++sp & 255u) == 0u) { if (xb_ld(&bar[XB_TMO])) break; if (sp > XB_SPIN_CAP) { atomicAdd(&bar[XB_TMO], 1u); break; } }
    }
    nloc = mine > 0u ? mine : 1u; nx = cnt > 0u ? cnt : 1u;
}

__device__ __forceinline__ void xcd_barrier(const XcdBarrier& b) {
    asm volatile("s_waitcnt vmcnt(0)" ::: "memory");
    __syncthreads();
    if (threadIdx.x == 0) {
        unsigned* bar = b.bar;
        __builtin_amdgcn_s_waitcnt(0);
        unsigned nloc = b.st[0], nx = b.st[1];
        if (nloc == 0u) { xcd_barrier_complete(bar, b.x, nloc, nx); b.st[0] = nloc; b.st[1] = nx; }
        const unsigned old = xb_add(&bar[XB_XSUB(b.x)], 1u);
        const unsigned gen = old / nloc;
        if (old + 1u == (gen + 1u) * nloc) {
            __builtin_amdgcn_fence(__ATOMIC_RELEASE, "agent");
            asm volatile("s_waitcnt vmcnt(0)" ::: "memory");
            const unsigned og = xb_add(&bar[XB_TOP], 1u);
            const unsigned tg = og / nx;
            if (og + 1u == (tg + 1u) * nx) xb_add(&bar[XB_TOPGEN], 1u);
            else XB_SPIN(xb_ld(&bar[XB_TOPGEN]) == tg, bar);
            __builtin_amdgcn_fence(__ATOMIC_ACQUIRE, "agent");
            xb_add(&bar[XB_XGEN(b.x)], 1u);
            asm volatile("s_waitcnt vmcnt(0)" ::: "memory");
        } else {
            XB_SPIN(xb_ld(&bar[XB_XGEN(b.x)]) == gen, bar);
            __builtin_amdgcn_fence(__ATOMIC_ACQUIRE, "agent");
            asm volatile("s_waitcnt vmcnt(0)" ::: "memory");
        }
    }
    __syncthreads();
}


constexpr int FX_CNT_WORD = 16384;
struct RowStats {
    float* slots;
    unsigned* cnt;
    __device__ __forceinline__ void run(const pg8::f32x4 (&v)[2][2][4][2], const pg8::Unit& u, int wr, int wc, int fr, int fq, LAS unsigned char* lds, int wid, int lane) const {
        LAS float* P = (LAS float*)lds;
        LAS float* S = (LAS float*)(lds + 8192);
#pragma unroll
        for (int ai = 0; ai < 2; ++ai)
#pragma unroll
            for (int mm = 0; mm < 4; ++mm) {
                float s = 0.f;
#pragma unroll
                for (int bj = 0; bj < 2; ++bj)
#pragma unroll
                    for (int n = 0; n < 2; ++n) { const pg8::f32x4 x = v[ai][bj][mm][n]; s += (x[0] * x[0] + x[1] * x[1]) + (x[2] * x[2] + x[3] * x[3]); }
                s += __shfl_xor(s, 16); s += __shfl_xor(s, 32);
                if (fq == 0) P[(ai * 128 + wr * 64 + mm * 16 + fr) * 4 + wc] = s;
            }
        asm volatile("s_waitcnt lgkmcnt(0)" ::: "memory"); __builtin_amdgcn_s_barrier(); asm volatile("" ::: "memory");
        const int row = wid * 32 + (lane & 31);
        if (lane < 32) {
            const float t = (P[row * 4 + 0] + P[row * 4 + 1]) + (P[row * 4 + 2] + P[row * 4 + 3]);
            __hip_atomic_store(slots + ((size_t)(u.pm * 256 + row) * 4 + u.pn), t, __ATOMIC_RELAXED, __HIP_MEMORY_SCOPE_AGENT);
        }
        asm volatile("s_waitcnt vmcnt(0)" ::: "memory");
        if (lane == 0) __hip_atomic_fetch_add(cnt + 64 * u.pm, 1u, __ATOMIC_RELAXED, __HIP_MEMORY_SCOPE_AGENT);
        if (wid == 0) { unsigned sp = 0;
            while ((unsigned)__builtin_amdgcn_readfirstlane(__hip_atomic_load(cnt + 64 * u.pm, __ATOMIC_RELAXED, __HIP_MEMORY_SCOPE_AGENT)) < 32u && ++sp < (1u << 22)) __builtin_amdgcn_s_sleep(1); }
        asm volatile("s_waitcnt vmcnt(0) lgkmcnt(0)" ::: "memory"); __builtin_amdgcn_s_barrier(); asm volatile("" ::: "memory");
        if (lane < 32) {
            const float* sl = slots + (size_t)(u.pm * 256 + row) * 4; float t = 0.f;
#pragma unroll
            for (int k = 0; k < 4; ++k) t += __hip_atomic_load(sl + k, __ATOMIC_RELAXED, __HIP_MEMORY_SCOPE_AGENT);
            S[row] = t;
        }
        asm volatile("s_waitcnt vmcnt(0) lgkmcnt(0)" ::: "memory"); __builtin_amdgcn_s_barrier(); asm volatile("" ::: "memory");
    }
};
struct EpiRmsRes {
    static constexpr bool PERM = true, AFTER_DRAIN = true;
    const void* xin; void* xout; const float* gpost; float* rsout; RowStats st1, st2; int xin32, last;
    __device__ __forceinline__ void fused(pg8::f32x4 (&acc)[2][2][4][2], const pg8::Unit& u, int wr, int wc, int fr, int fq, LAS unsigned char* lds, int wid, int lane) const {
        const LAS float* S = (const LAS float*)(lds + 8192);
        const int col0 = u.pn * 256 + wc * 64 + 8 * fq;
        u32x4 xpre[2][4][2];
        if (!xin32) {
#pragma unroll
            for (int ai = 0; ai < 2; ++ai)
#pragma unroll
                for (int mm = 0; mm < 4; ++mm) { const size_t off = (size_t)(u.pm * 256 + ai * 128 + wr * 64 + mm * 16 + fr) * DM + col0;
#pragma unroll
                    for (int bj = 0; bj < 2; ++bj) xpre[ai][mm][bj] = *(const u32x4*)((const bf16*)xin + off + bj * 32); }
        }
        st1.run(acc, u, wr, wc, fr, fq, lds, wid, lane);
        pg8::f32x4 gv[2][2];
#pragma unroll
        for (int bj = 0; bj < 2; ++bj)
#pragma unroll
            for (int n = 0; n < 2; ++n) gv[bj][n] = *(const pg8::f32x4*)(gpost + col0 + bj * 32 + n * 4);
#pragma unroll
        for (int ai = 0; ai < 2; ++ai)
#pragma unroll
            for (int mm = 0; mm < 4; ++mm) {
                const int r = ai * 128 + wr * 64 + mm * 16 + fr; const float rs = __builtin_amdgcn_rsqf(S[r] * (1.f / DM) + EPS);
                const size_t off = (size_t)(u.pm * 256 + r) * DM + col0;
#pragma unroll
                for (int bj = 0; bj < 2; ++bj) {
                    pg8::f32x4 xa, xb;
                    if (xin32) { xa = *(const pg8::f32x4*)((const float*)xin + off + bj * 32); xb = *(const pg8::f32x4*)((const float*)xin + off + bj * 32 + 4); }
                    else { const u32x4 w = xpre[ai][mm][bj]; xa = (pg8::f32x4){bflo(w.x), bfhi(w.x), bflo(w.y), bfhi(w.y)}; xb = (pg8::f32x4){bflo(w.z), bfhi(w.z), bflo(w.w), bfhi(w.w)}; }
                    const pg8::f32x4 ya = xa + acc[ai][bj][mm][0] * rs * gv[bj][0], yb = xb + acc[ai][bj][mm][1] * rs * gv[bj][1];
                    acc[ai][bj][mm][0] = ya; acc[ai][bj][mm][1] = yb;
                    if (last) { *(pg8::f32x4*)((float*)xout + off + bj * 32) = ya; *(pg8::f32x4*)((float*)xout + off + bj * 32 + 4) = yb; }
                    else { u32x4 w; w.x = pk2(ya[0], ya[1]); w.y = pk2(ya[2], ya[3]); w.z = pk2(yb[0], yb[1]); w.w = pk2(yb[2], yb[3]); *(u32x4*)((bf16*)xout + off + bj * 32) = w; }
                }
                if (mm & 1) asm volatile("" ::: "memory");
            }
        if (!last) {
            st2.run(acc, u, wr, wc, fr, fq, lds, wid, lane);
            if (u.pn == 0 && wc == 0 && fq == 0) {
#pragma unroll
                for (int ai = 0; ai < 2; ++ai)
#pragma unroll
                    for (int mm = 0; mm < 4; ++mm) { const int r = ai * 128 + wr * 64 + mm * 16 + fr; rsout[u.pm * 256 + r] = __builtin_amdgcn_rsqf(S[r] * (1.f / DM) + EPS); }
            }
        }
        asm volatile("s_waitcnt lgkmcnt(0)" ::: "memory"); __builtin_amdgcn_s_barrier(); asm volatile("" ::: "memory");
    }
};
struct OneUnit {
    pg8::StaticOrder base; int round;
    __device__ __forceinline__ bool next(int i, pg8::Unit& u) const { return i == 0 && base.next(round, u); }
    __device__ __forceinline__ void a_ready(const pg8::Unit&) const {}
    __device__ __forceinline__ void done(const pg8::Unit&) const {}
};

#ifndef REP_SYNC
#define REP_SYNC 1
#endif
#define GSYNC() do { for (int rs_ = 0; rs_ < REP_SYNC; ++rs_) xcd_barrier(xbar); } while (0)
struct Args { const float* in[16]; float* out; unsigned char* ws; };

__global__ void __launch_bounds__(NWAVES * 64, 2) mega_fwd(Args args) {
    extern __shared__ __attribute__((aligned(16))) unsigned char lds_raw[];
    cg::grid_group grid = cg::this_grid();
    LAS unsigned char* lds = (LAS unsigned char*)lds_raw;
    const int tid = threadIdx.x, lane = tid & 63, wave = __builtin_amdgcn_readfirstlane(tid >> 6);
    const int G = gridDim.x, bx = blockIdx.x;
    const int gw = bx * NWAVES + wave, NGW = G * NWAVES;
    unsigned char* ws = args.ws;
    const float* x_in = args.in[0];
    float* xres = args.out;
    bf16* Hb = (bf16*)(ws + WS_H); bf16* MB = (bf16*)(ws + WS_MB); bf16* XR = (bf16*)(ws + WS_XR); float* LSE = (float*)(ws + WS_LSE);
    float* RS1 = (float*)(ws + WS_RS1); float* RS2 = (float*)(ws + WS_RS2);
    bf16* Zb = (bf16*)(ws + WS_Z); bf16* MIX = (bf16*)(ws + WS_MIX); bf16* AB = (bf16*)(ws + WS_A);

    unsigned* barw = (unsigned*)(ws + WS_CTL);
    if (bx == 0) for (int i = tid; i < XCD_BAR_WORDS; i += NWAVES * 64) __hip_atomic_store(barw + i, 0u, __ATOMIC_RELAXED, __HIP_MEMORY_SCOPE_AGENT);
    if (tid < 2) ((volatile LAS unsigned*)(lds + XB_LDS_OFF))[tid] = 0u;
    for (int i = bx * (NWAVES * 64) + tid; i < 16 * 128 * 64; i += G * NWAVES * 64) __hip_atomic_store(barw + FX_CNT_WORD + i, 0u, __ATOMIC_RELAXED, __HIP_MEMORY_SCOPE_AGENT);
#ifndef REP_P0
#define REP_P0 1
#endif
    for (int rep_ = 0; rep_ < REP_P0; ++rep_) {
        LAS float* scr = (LAS float*)(lds + wave * 16384);
        constexpr int I_IN = (DM / 64) * (INW / 32), I_OUT = (DM / 64) * (DM / 32), I_F1 = (DM / 64) * (DFF / 32), I_F2 = (DFF / 64) * (DM / 32);
        constexpr int I_LAYER = I_IN + I_OUT + I_F1 + I_F2;
        for (int it = gw; it < DEPTH * I_LAYER; it += NGW) {
            const int l = it / I_LAYER; int r = it % I_LAYER;
            if (r < I_IN) { p0_transpose_item(args.in[5] + (size_t)l * DM * INW, DM, INW, (bf16*)(ws + WS_WIN) + (size_t)l * INW * DM, scr, r, lane, args.in[1] + l * DM); continue; } r -= I_IN;
            if (r < I_OUT) { p0_transpose_item(args.in[13] + (size_t)l * DM * DM, DM, DM, (bf16*)(ws + WS_WOUT) + (size_t)l * DM * DM, scr, r, lane, nullptr); continue; } r -= I_OUT;
            if (r < I_F1) { p0_transpose_item(args.in[14] + (size_t)l * DM * DFF, DM, DFF, (bf16*)(ws + WS_WFF1) + (size_t)l * DFF * DM, scr, r, lane, args.in[3] + l * DM); continue; } r -= I_F1;
            p0_transpose_item(args.in[15] + (size_t)l * DFF * DM, DFF, DM, (bf16*)(ws + WS_WFF2) + (size_t)l * DM * DFF, scr, r, lane, nullptr);
        }
        if (M % (4 * NGW) == 0) { for (int m = gw; m < M; m += 4 * NGW) rms_rows_to_bf16<4>(x_in, RS1, XR, m, NGW, lane); }
        else { for (int m = gw; m < M; m += NGW) rms_rows_to_bf16<1>(x_in, RS1, XR, m, NGW, lane); }
    }
    __syncthreads();
    grid.sync();
    XcdBarrier xbar = xcd_barrier_post(barw, (volatile LAS unsigned*)(lds + XB_LDS_OFF));

    for (int l = 0; l < DEPTH; ++l) {
        {
            pg8::Gemm g{XR, (const bf16*)(ws + WS_WIN) + (size_t)l * INW * DM, M, INW, DM}; pg8::StaticOrder S; S.init(M, INW, G, bx);
            pg8::EpiBf16<0> E{Zb, INW, nullptr, AW, (size_t)AW, QSCALE, RS1, lds + XEPI_LDS_OFF};
            pg8::gemm_phase<pg8::EpiBf16<0>, pg8::StaticOrder, PG8_ALIGN, PG8_SP2>(lds, g, S, E);
        }
        GSYNC();
#ifndef REP_MIX
#define REP_MIX 1
#endif
        for (int rep_ = 0; rep_ < REP_MIX; ++rep_) {
#ifndef REP_LRU
#define REP_LRU 1
#endif
            for (int rl_ = 0; rl_ < REP_LRU; ++rl_)
            for (int u0 = bx; u0 < NB * 8 * 4; u0 += G) { const int u = ((G & 7) == 0 && G == NB * 8 * 4) ? (u0 & 7) * (G >> 3) + (u0 >> 3) : u0;
                lru_unit(u, Zb, MIX, args.in[6] + (size_t)l * 4 * LW, args.in[7] + (size_t)l * LW, args.in[8] + (size_t)l * 8 * 64 * 64, args.in[9] + (size_t)l * LW,
                         args.in[10] + (size_t)l * 8 * 64 * 64, args.in[11] + (size_t)l * LW, args.in[12] + (size_t)l * LW, lds); }
            AttPre P = {};
#define ATT_UIDX(k) (((((k) * (G >> 3) + (bx >> 3)) / 48) * 8 + (bx & 7)) * 48 + (((k) * (G >> 3) + (bx >> 3)) % 48))
            const int nk = ((G & 7) == 0 && ATT_UNITS % G == 0) ? ATT_UNITS / G : 0;
            int u = nk ? ATT_UIDX(0) : bx;
            if (u < ATT_UNITS) att_issue(u, Zb, P);
            for (int k = 0; u < ATT_UNITS; ++k) {
                const int unext = nk ? ((k + 1 < nk) ? ATT_UIDX(k + 1) : ATT_UNITS) : u + G;
                __syncthreads();
                att_stage(P, lds);
                const u32x4 qa0 = P.q[0], qa1 = P.q[1], qb0 = P.q[2], qb1 = P.q[3];
                __syncthreads();
                if (unext < ATT_UNITS) att_issue(unext, Zb, P);
                att_compute(u, 0, qa0, qa1, ws, LSE, lds);
                att_compute(u, 1, qb0, qb1, ws, LSE, lds);
                u = unext;
            }
#undef ATT_UIDX
        }
        GSYNC();
#ifndef REP_CMB
#define REP_CMB 1
#endif
        for (int rc_ = 0; rc_ < REP_CMB; ++rc_) { int t_ = threadIdx.x; asm volatile("" : "+v"(t_)); att_combine(ws, LSE, MIX, bx * (NWAVES * 64) + t_, G * NWAVES * 64); }
        GSYNC();
        for (int rnd = 0; rnd < 2; ++rnd) {
            pg8::Gemm g{MIX, (const bf16*)(ws + WS_WOUT) + (size_t)l * DM * DM, M, DM, DM}; OneUnit S; S.base.init(M, DM, G, bx); S.round = rnd;
            unsigned* cb = barw + FX_CNT_WORD + ((l * 2 + 0) * 2) * 128 * 64;
            EpiRmsRes E{(l == 0) ? (const void*)x_in : (const void*)XR, (void*)XR, args.in[2] + l * DM, RS2, RowStats{(float*)(ws + WS_FX1), cb}, RowStats{(float*)(ws + WS_FX2), cb + 128 * 64}, (l == 0) ? 1 : 0, 0};
            pg8::gemm_phase<EpiRmsRes, OneUnit, false, PG8_SP2>(lds, g, S, E);
        }
        GSYNC();
#ifndef REP_G3
#define REP_G3 1
#endif
        for (int rep_ = 0; rep_ < REP_G3; ++rep_) {
            pg8::Gemm g{XR, (const bf16*)(ws + WS_WFF1) + (size_t)l * DFF * DM, M, DFF, DM}; pg8::StaticOrder S; S.init(M, DFF, G, bx);
            pg8::EpiBf16<2> E{AB, DFF, nullptr, 0, 0, 1.f, RS2, lds + XEPI_LDS_OFF};
            pg8::gemm_phase<pg8::EpiBf16<2>, pg8::StaticOrder, PG8_ALIGN, PG8_SP2>(lds, g, S, E);
        }
        GSYNC();
        for (int rnd = 0; rnd < 2; ++rnd) {
            pg8::Gemm g{AB, (const bf16*)(ws + WS_WFF2) + (size_t)l * DM * DFF, M, DM, DFF}; OneUnit S; S.base.init(M, DM, G, bx); S.round = rnd;
            unsigned* cb = barw + FX_CNT_WORD + ((l * 2 + 1) * 2) * 128 * 64;
            const int lastl = (l + 1 == DEPTH) ? 1 : 0;
            EpiRmsRes E{(const void*)XR, lastl ? (void*)xres : (void*)XR, args.in[4] + l * DM, RS1, RowStats{(float*)(ws + WS_FX1), cb}, RowStats{(float*)(ws + WS_FX2), cb + 128 * 64}, 0, lastl};
            pg8::gemm_phase<EpiRmsRes, OneUnit, false, PG8_SP2>(lds, g, S, E);
        }
        if (l + 1 < DEPTH) GSYNC();
    }
}

extern "C" void kernel_launch(void* const* d_in, const int* in_sizes, int n_in, void* d_out, int out_size, void* d_ws, size_t ws_size, hipStream_t stream) {
    static int grid = 0;
    if (grid == 0) {
        if (n_in != 16 || in_sizes[0] != M * DM || out_size != M * DM || ws_size < WS_END) { fprintf(stderr, "kernel_launch: unexpected shapes (n_in %d, in0 %d, out %d, ws %zu); nothing launched\n", n_in, n_in > 0 ? in_sizes[0] : -1, out_size, ws_size); grid = -1; return; }
        int dev = 0, cus = 0, per_cu = 0;
        if (hipGetDevice(&dev) != hipSuccess || hipDeviceGetAttribute(&cus, hipDeviceAttributeMultiprocessorCount, dev) != hipSuccess) { grid = -1; return; }
        if (hipFuncSetAttribute((const void*)mega_fwd, hipFuncAttributeMaxDynamicSharedMemorySize, LDS_BYTES) != hipSuccess) { fprintf(stderr, "kernel_launch: hipFuncSetAttribute failed\n"); grid = -1; return; }
        if (hipOccupancyMaxActiveBlocksPerMultiprocessor(&per_cu, (const void*)mega_fwd, NWAVES * 64, LDS_BYTES) != hipSuccess || per_cu < 1) { fprintf(stderr, "kernel_launch: occupancy query says %d\n", per_cu); per_cu = 1; }
        (void)hipGetLastError();
        grid = cus * per_cu;
    }
    if (grid < 0) return;
    Args a{};
    for (int i = 0; i < 16; ++i) a.in[i] = (const float*)d_in[i];
    a.out = (float*)d_out; a.ws = (unsigned char*)d_ws;
    void* kargs[] = {&a};
    hipError_t e = hipLaunchCooperativeKernel((const void*)mega_fwd, dim3(grid), dim3(NWAVES * 64), kargs, LDS_BYTES, stream);
    if (e != hipSuccess) fprintf(stderr, "kernel_launch: cooperative launch failed: %s (grid %d)\n", hipGetErrorString(e), grid);
}
```

```cpp
#include <hip/hip_runtime.h>
#include <hip/hip_cooperative_groups.h>
#include <cstdio>
#include <cstdint>
namespace cg = cooperative_groups;
namespace pg8 {
#define PG8_LAS __attribute__((address_space(3)))
typedef unsigned short bf16_t;
typedef short bf16x8 __attribute__((ext_vector_type(8)));
typedef float f32x4 __attribute__((ext_vector_type(4)));
typedef unsigned u32x4 __attribute__((ext_vector_type(4)));
constexpr int BM = 256, BK = 64, HALF = 128, HTB = HALF * BK * 2  , STAGE_BYTES = 8 * HTB, NXCD = 8, WGM = 8;

__host__ __device__ __forceinline__ int lds_byte(int r, int c) { const int st = (r >> 4) * 2 + (c >> 5), rr = r & 15, cc = c & 31, ob = rr * 64 + cc * 2; return st * 1024 + (ob ^ (((ob >> 9) & 1) << 5)); }
__host__ __device__ __forceinline__ void stage_rc(int b, int& R, int& C) { const int st = b / 1024, sb = b % 1024, swz = sb ^ (((sb >> 9) & 1) << 5); R = (st >> 1) * 16 + swz / 64; C = (st & 1) * 32 + (swz % 64) / 2; }
__host__ __device__ __forceinline__ int perm32(int rho) { const int n = rho >> 4, i = rho & 15; return 8 * (i >> 2) + 4 * n + (i & 3); }

struct Unit { int pm, pn; };
struct Gemm { const bf16_t* A; const bf16_t* Bt; int M, N, K; };

struct StaticOrder {
    int nM, nN, nwg, G, c;
    __host__ __device__ void init(int M, int N, int G_, int c_) { nM = M / BM; nN = N / BM; nwg = nM * nN; G = G_; c = c_; }
    __host__ __device__ bool next(int i, Unit& u) const {
        const long L = (long)i * G + c; if (L >= nwg) return false;
        int wgid = (int)L; { const int q = nwg / NXCD, r = nwg % NXCD, xcd = wgid % NXCD, off = wgid / NXCD; wgid = (xcd < r ? xcd * (q + 1) : r * (q + 1) + (xcd - r) * q) + off; }
        const int nig = WGM * nN, gid = wgid / nig, fm = gid * WGM, gsz = (nM - fm) < WGM ? (nM - fm) : WGM;
        u.pm = fm + ((wgid % nig) % gsz); u.pn = (wgid % nig) / gsz; return true;
    }
    __device__ __forceinline__ void a_ready(const Unit&) const {}
    __device__ __forceinline__ void done(const Unit&) const {}
};

__device__ __forceinline__ unsigned cvt_pk_bf16(float lo, float hi) { unsigned r; asm volatile("v_cvt_pk_bf16_f32 %0, %1, %2" : "=v"(r) : "v"(lo), "v"(hi)); return r; }
typedef float f32x2 __attribute__((ext_vector_type(2)));
__device__ __forceinline__ f32x2 gelu_pk(f32x2 v) {
    const f32x2 av = __builtin_elementwise_abs(v), d = av * 0.2316418882f + 1.0f;
    f32x2 t; t.x = __builtin_amdgcn_rcpf(d.x); t.y = __builtin_amdgcn_rcpf(d.y);
    f32x2 q = t * 0.5307027145f + (-0.7265760135f); q = q * t + 0.7107068705f; q = q * t + (-0.142248368f); q = q * t + 0.127414796f; q = q * t;
    const f32x2 s = (v * v) * (-0.72134752044f);
    f32x2 e; e.x = __builtin_amdgcn_exp2f(s.x); e.y = __builtin_amdgcn_exp2f(s.y);
    const f32x2 m = v * (q * e), r = v - m;
    f32x2 o; o.x = v.x < 0.f ? m.x : r.x; o.y = v.y < 0.f ? m.y : r.y; return o;
}

template <int ACT  > struct EpiBf16 {
    static constexpr bool PERM = true, AFTER_DRAIN = false; static_assert(ACT == 0 || ACT == 1 || ACT == 2, "EpiBf16: ACT is 0 (none), 1 (gelu_pk) or 2 (squared relu)");
    bf16_t* O; int ldc; const float* bias; int split_cols; size_t split_stride; float scale0; const float* rowscale; PG8_LAS unsigned char* xlds;
    __device__ __forceinline__ void operator()(const f32x4 (&acc)[2][2][4][2], const Unit& u, int wr, int wc, int fr, int fq) const {
        const int row0 = u.pm * BM + wr * 64 + fr; int colt = u.pn * BM; bf16_t* base = O;
        float sc = 1.f; if (split_cols) { const int t = colt / split_cols; base += (size_t)t * split_stride; colt -= t * split_cols; if (t == 0) sc = scale0; }
        const int col0 = colt + wc * 64 + 8 * fq, bcol0 = u.pn * BM + wc * 64 + 8 * fq;
        const int lane_ = fq * 16 + fr; PG8_LAS unsigned char* xw = xlds ? xlds + (wr * 4 + wc) * 2048 : xlds;
        float rs8[8];
#pragma unroll
        for (int i = 0; i < 8; ++i) rs8[i] = rowscale ? rowscale[row0 + (i >> 2) * HALF + (i & 3) * 16] : 1.f;
        f32x4 bv[2][2];
#pragma unroll
        for (int bj = 0; bj < 2; ++bj)
#pragma unroll
            for (int n = 0; n < 2; ++n) bv[bj][n] = bias ? *(const f32x4*)(bias + bcol0 + bj * 32 + 4 * n) : (f32x4){0.f, 0.f, 0.f, 0.f};
#pragma unroll
        for (int ai = 0; ai < 2; ++ai)
#pragma unroll
            for (int m = 0; m < 4; ++m) { bf16_t* rowp = base + (size_t)(row0 + ai * HALF + m * 16) * ldc + col0; const float rsv = rs8[ai * 4 + m];
#pragma unroll
                for (int bj = 0; bj < 2; ++bj) { f32x4 v0 = (acc[ai][bj][m][0] + bv[bj][0]) * rsv, v1 = (acc[ai][bj][m][1] + bv[bj][1]) * rsv;
                    if (ACT == 1) { f32x2 a = gelu_pk((f32x2){v0[0], v0[1]}), b = gelu_pk((f32x2){v0[2], v0[3]}), c = gelu_pk((f32x2){v1[0], v1[1]}), d = gelu_pk((f32x2){v1[2], v1[3]});
                        v0 = (f32x4){a.x, a.y, b.x, b.y}; v1 = (f32x4){c.x, c.y, d.x, d.y}; }
                    if (ACT == 2) { _Pragma("unroll") for (int e = 0; e < 4; ++e) { const float p0 = __builtin_fmaxf(v0[e], 0.f), p1 = __builtin_fmaxf(v1[e], 0.f); v0[e] = p0 * p0; v1[e] = p1 * p1; } }
                    v0 = v0 * sc; v1 = v1 * sc; u32x4 w; w.x = cvt_pk_bf16(v0[0], v0[1]); w.y = cvt_pk_bf16(v0[2], v0[3]); w.z = cvt_pk_bf16(v1[0], v1[1]); w.w = cvt_pk_bf16(v1[2], v1[3]);
                    if (xlds) *(PG8_LAS u32x4*)(xw + fr * 128 + (((bj * 4 + fq) ^ (fr & 7)) << 4)) = w;
                    else *(u32x4*)(rowp + bj * 32) = w; }
                if (xlds) { asm volatile("s_waitcnt lgkmcnt(0)" ::: "memory");
                    bf16_t* gp = base + (size_t)(u.pm * BM + wr * 64 + ai * HALF + m * 16) * ldc + colt + wc * 64;
#pragma unroll
                    for (int hh = 0; hh < 2; ++hh) { const int rr = (lane_ >> 3) + 8 * hh, ch = lane_ & 7;
                        const u32x4 t = *(const PG8_LAS u32x4*)(xw + rr * 128 + ((ch ^ (rr & 7)) << 4));
                        *(u32x4*)(gp + (size_t)rr * ldc + ch * 8) = t; }
                    asm volatile("s_waitcnt lgkmcnt(0)" ::: "memory"); } }
    }
};
template <class Epi, class Sched, bool ALIGN_EPI = false, bool SP2 = false>
__device__ __forceinline__ void gemm_phase(PG8_LAS unsigned char* lds, const Gemm g, const Sched& S, const Epi& E) {
    int tid_ = threadIdx.x; asm volatile("" : "+v"(tid_));
    const int tid = tid_, wid = __builtin_amdgcn_readfirstlane(tid >> 6), lane = tid & 63, wr = wid >> 2, wc = wid & 3, fr = lane & 15, fq = lane >> 4;
    const int K = g.K, nt = K / BK;
    unsigned voffA[2], voffB[2];
#pragma unroll
    for (int i = 0; i < 2; ++i) { int R, C; stage_rc(tid * 16 + i * 8192, R, C); const int Rb = Epi::PERM ? (64 * (R >> 5) + perm32(R & 31)) : R;
        voffA[i] = (unsigned)(R * K + C) * 2u; voffB[i] = (unsigned)(Rb * K + C) * 2u; }
    const size_t kstep = (size_t)(BK * 2);
    const size_t hstep = (size_t)HALF * K * 2;
    const size_t hstepB = Epi::PERM ? (size_t)32 * K * 2 : hstep;
    const size_t tstep = 2 * hstep;
    const unsigned ldsw = (unsigned)wid * 1024u;
    const int aoff = lds_byte(wr * 64 + fr, fq * 8), boff = lds_byte(wc * 32 + fr, fq * 8);
#define PG8_SA(b, h) (((b) * 2 + (h)) * HTB)
#define PG8_SB(b, h) ((4 + (b) * 2 + (h)) * HTB)
#define PG8_STAGE(bufoff, gbase, voff) do { _Pragma("unroll") for (int _i = 0; _i < 2; ++_i) \
        __builtin_amdgcn_global_load_lds((const unsigned*)((const char*)(gbase) + (voff)[_i]), (PG8_LAS unsigned*)(lds + (bufoff) + ldsw + _i * 8192), 16, 0, 0); } while (0)
#define PG8_LDA(dst, b, h) do { _Pragma("unroll") for (int m = 0; m < 4; ++m) _Pragma("unroll") for (int k = 0; k < 2; ++k) dst[m][k] = *(const PG8_LAS bf16x8*)(lds + PG8_SA(b, h) + aoff + m * 2048 + k * 1024); } while (0)
#define PG8_LDB(dst, b, h) do { _Pragma("unroll") for (int n = 0; n < 2; ++n) _Pragma("unroll") for (int k = 0; k < 2; ++k) dst[n][k] = *(const PG8_LAS bf16x8*)(lds + PG8_SB(b, h) + boff + n * 2048 + k * 1024); } while (0)
#define PG8_MMA(ai, bj, At, Bt) do { __builtin_amdgcn_s_setprio(1); _Pragma("unroll") for (int m = 0; m < 4; ++m) _Pragma("unroll") for (int n = 0; n < 2; ++n) _Pragma("unroll") for (int k = 0; k < 2; ++k) \
        acc[ai][bj][m][n] = __builtin_amdgcn_mfma_f32_16x16x32_bf16(Bt[n][k], At[m][k], acc[ai][bj][m][n], 0, 0, 0); __builtin_amdgcn_s_setprio(0); } while (0)
#define PG8_WAIT_V(n) asm volatile("s_waitcnt vmcnt(" #n ")" ::: "memory")
#define PG8_WAIT_L(n) asm volatile("s_waitcnt lgkmcnt(" #n ")" ::: "memory")
#define PG8_BAR __builtin_amdgcn_s_barrier()
#define PG8_SCHED __builtin_amdgcn_sched_barrier(0)
    Unit cur, nxt; int ui = 0;
    if (!S.next(0, cur)) return;
    f32x4 acc[2][2][4][2];
#pragma unroll
    for (int a = 0; a < 2; ++a)
#pragma unroll
        for (int b = 0; b < 2; ++b)
#pragma unroll
            for (int m = 0; m < 4; ++m)
#pragma unroll
                for (int n = 0; n < 2; ++n) acc[a][b][m][n] = (f32x4){0.f, 0.f, 0.f, 0.f};
    bf16x8 At[4][2], B0[2][2], B1[2][2];
    const char* cA = (const char*)g.A + (size_t)cur.pm * tstep; const char* cB = (const char*)g.Bt + (size_t)cur.pn * tstep;
    S.a_ready(cur);
    if constexpr (SP2) {
        PG8_STAGE(PG8_SB(0, 0), cB, voffB); PG8_STAGE(PG8_SB(0, 1), cB + hstepB, voffB); PG8_STAGE(PG8_SA(0, 0), cA, voffA); PG8_STAGE(PG8_SA(0, 1), cA + hstep, voffA);
        if (wr == 1) PG8_BAR;
        PG8_WAIT_V(2); PG8_BAR;
        PG8_STAGE(PG8_SB(1, 0), cB + kstep, voffB); PG8_STAGE(PG8_SA(1, 0), cA + kstep, voffA); PG8_STAGE(PG8_SB(1, 1), cB + hstepB + kstep, voffB);
        PG8_WAIT_V(6); PG8_BAR;
    } else {
        PG8_STAGE(PG8_SB(0, 0), cB, voffB); PG8_STAGE(PG8_SA(0, 0), cA, voffA); PG8_STAGE(PG8_SB(0, 1), cB + hstepB, voffB); PG8_STAGE(PG8_SA(0, 1), cA + hstep, voffA);
        if (wr == 1) PG8_BAR;
        PG8_WAIT_V(4); PG8_BAR;
        PG8_STAGE(PG8_SB(1, 0), cB + kstep, voffB); PG8_STAGE(PG8_SA(1, 0), cA + kstep, voffA); PG8_STAGE(PG8_SB(1, 1), cB + hstepB + kstep, voffB);
        PG8_WAIT_V(6); PG8_BAR;
    }
    for (;;) {
        const bool has_next = S.next(ui + 1, nxt);
        const char* nA = has_next ? (const char*)g.A + (size_t)nxt.pm * tstep : cA; const char* nB = has_next ? (const char*)g.Bt + (size_t)nxt.pn * tstep : cB;
        for (int t = 0; t < nt; t += 2) {
            const bool last = (t == nt - 2);
            const char* a1 = cA + (size_t)(t + 1) * kstep;
            const char* a2 = last ? nA : cA + (size_t)(t + 2) * kstep; const char* b2 = last ? nB : cB + (size_t)(t + 2) * kstep;
            const char* a3 = a2 + kstep; const char* b3 = b2 + kstep;
            if (last && has_next) S.a_ready(nxt);
            if constexpr (SP2) {
            PG8_LDB(B0, 0, 0); PG8_LDB(B1, 0, 1); PG8_SCHED; PG8_LDA(At, 0, 0); PG8_STAGE(PG8_SA(1, 1), a1 + hstep, voffA);
            PG8_WAIT_V(8); PG8_WAIT_L(0); PG8_BAR; PG8_MMA(0, 0, At, B0); PG8_MMA(0, 1, At, B1); PG8_BAR; PG8_SCHED;
            PG8_LDA(At, 0, 1); PG8_STAGE(PG8_SB(0, 0), b2, voffB); PG8_STAGE(PG8_SB(0, 1), b2 + hstepB, voffB); PG8_STAGE(PG8_SA(0, 0), a2, voffA);
            PG8_WAIT_V(8); PG8_WAIT_L(0); PG8_BAR; PG8_MMA(1, 0, At, B0); PG8_MMA(1, 1, At, B1); PG8_BAR; PG8_SCHED;
            PG8_LDB(B0, 1, 0); PG8_LDB(B1, 1, 1); PG8_SCHED; PG8_LDA(At, 1, 0); PG8_STAGE(PG8_SA(0, 1), a2 + hstep, voffA);
            PG8_WAIT_V(8); PG8_WAIT_L(0); PG8_BAR; PG8_MMA(0, 0, At, B0); PG8_MMA(0, 1, At, B1); PG8_BAR; PG8_SCHED;
            PG8_LDA(At, 1, 1); PG8_STAGE(PG8_SB(1, 0), b3, voffB); PG8_STAGE(PG8_SB(1, 1), b3 + hstepB, voffB); PG8_STAGE(PG8_SA(1, 0), a3, voffA);
            PG8_WAIT_V(8); PG8_WAIT_L(0); PG8_BAR; PG8_MMA(1, 0, At, B0); PG8_MMA(1, 1, At, B1); PG8_BAR; PG8_SCHED;
            } else {
            PG8_LDB(B0, 0, 0); PG8_SCHED; PG8_LDA(At, 0, 0); PG8_STAGE(PG8_SA(1, 1), a1 + hstep, voffA);
            PG8_WAIT_L(8); PG8_BAR; PG8_WAIT_L(0); PG8_MMA(0, 0, At, B0); PG8_BAR; PG8_SCHED;
            PG8_LDB(B1, 0, 1); PG8_STAGE(PG8_SB(0, 0), b2, voffB);
            PG8_BAR; PG8_WAIT_L(0); PG8_MMA(0, 1, At, B1); PG8_BAR;
            PG8_LDA(At, 0, 1); PG8_STAGE(PG8_SA(0, 0), a2, voffA);
            PG8_BAR; PG8_WAIT_L(0); PG8_MMA(1, 0, At, B0); PG8_BAR; PG8_SCHED;
            PG8_STAGE(PG8_SB(0, 1), b2 + hstepB, voffB);
            PG8_WAIT_V(6); PG8_BAR; PG8_MMA(1, 1, At, B1); PG8_BAR;
            PG8_LDB(B0, 1, 0); PG8_SCHED; PG8_LDA(At, 1, 0); PG8_STAGE(PG8_SA(0, 1), a2 + hstep, voffA);
            PG8_WAIT_L(8); PG8_BAR; PG8_WAIT_L(0); PG8_MMA(0, 0, At, B0); PG8_BAR; PG8_SCHED;
            PG8_LDB(B1, 1, 1); PG8_STAGE(PG8_SB(1, 0), b3, voffB);
            PG8_BAR; PG8_WAIT_L(0); PG8_MMA(0, 1, At, B1); PG8_BAR;
            PG8_LDA(At, 1, 1); PG8_STAGE(PG8_SA(1, 0), a3, voffA);
            PG8_BAR; PG8_WAIT_L(0); PG8_MMA(1, 0, At, B0); PG8_BAR; PG8_SCHED;
            PG8_STAGE(PG8_SB(1, 1), b3 + hstepB, voffB);
            PG8_WAIT_V(6); PG8_BAR; PG8_MMA(1, 1, At, B1); PG8_BAR;
            }
        }
        if constexpr (ALIGN_EPI) { if (wr == 0) PG8_BAR; }
        if constexpr (!Epi::AFTER_DRAIN) { E(acc, cur, wr, wc, fr, fq); S.done(cur); }
        if (!has_next) break;
#pragma unroll
        for (int a = 0; a < 2; ++a)
#pragma unroll
            for (int b = 0; b < 2; ++b)
#pragma unroll
                for (int m = 0; m < 4; ++m)
#pragma unroll
                    for (int n = 0; n < 2; ++n) acc[a][b][m][n] = (f32x4){0.f, 0.f, 0.f, 0.f};
        cur = nxt; cA = nA; cB = nB; ++ui;
        if constexpr (ALIGN_EPI) { if (wr == 1) PG8_BAR; }
    }
    PG8_WAIT_V(0);
    if constexpr (!ALIGN_EPI) { if (wr == 0) PG8_BAR; }
    PG8_BAR;
    if constexpr (Epi::AFTER_DRAIN) { E.fused(acc, cur, wr, wc, fr, fq, lds, wid, lane); S.done(cur); }
#undef PG8_SA
#undef PG8_SB
#undef PG8_STAGE
#undef PG8_LDA
#undef PG8_LDB
#undef PG8_MMA
#undef PG8_WAIT_V
#undef PG8_WAIT_L
#undef PG8_BAR
#undef PG8_SCHED
}
}

#ifndef PG8_SP2
#define PG8_SP2 true
#endif
#ifndef PG8_ALIGN
#define PG8_ALIGN true
#endif

constexpr int NB = 8, SEQ = 4096, DM = 1024, DEPTH = 4, NH = 8, HD = 64, AW = 512, LW = 512, INW = 2560, DFF = 4096;
constexpr int M = NB * SEQ;
constexpr float EPS = 1e-6f;
constexpr float QSCALE = 0.125f * 1.4426950408889634f;

constexpr size_t MiB = 1u << 20;
constexpr size_t WS_CTL = 0;
constexpr size_t WS_WIN = 1 * MiB, WS_WOUT = 21 * MiB, WS_WFF1 = 29 * MiB, WS_WFF2 = 61 * MiB;
constexpr size_t WS_H = 96 * MiB;
constexpr size_t WS_XR = 160 * MiB;
constexpr size_t WS_MB = 224 * MiB;
constexpr size_t WS_OP01 = 96 * MiB;
constexpr size_t WS_OP2 = 448 * MiB;
constexpr size_t WS_LSE = 480 * MiB;
constexpr size_t WS_Z = 224 * MiB;
constexpr size_t WS_MIX = 384 * MiB;
constexpr size_t WS_A = 224 * MiB;
constexpr size_t WS_RS1 = 484 * MiB;
constexpr size_t WS_RS2 = 484 * MiB + 262144;
constexpr size_t WS_FX1 = 485 * MiB, WS_FX2 = 485 * MiB + 524288;
constexpr size_t WS_END = 486 * MiB;
__device__ __forceinline__ unsigned short* op_base(unsigned char* ws, int p) { return (unsigned short*)(ws + (p == 2 ? WS_OP2 : WS_OP01 + (size_t)p * (32 * MiB))); }

constexpr int LDS_BYTES = 151552;
constexpr int XEPI_LDS_OFF = 133120;
constexpr int NWAVES = 8;

#define LAS __attribute__((address_space(3)))
typedef unsigned short bf16;
typedef short bf16x8 __attribute__((ext_vector_type(8)));
typedef short s16x4 __attribute__((ext_vector_type(4)));
typedef float f32x4 __attribute__((ext_vector_type(4)));
typedef unsigned u32x4 __attribute__((ext_vector_type(4)));
typedef unsigned u32x2 __attribute__((ext_vector_type(2)));

__device__ __forceinline__ unsigned f2bf(float f) { unsigned u = __builtin_bit_cast(unsigned, f); return (u + 0x7fffu + ((u >> 16) & 1u)) >> 16; }
typedef float f32x2_t __attribute__((ext_vector_type(2))); typedef __bf16 bf16x2_t __attribute__((ext_vector_type(2)));
__device__ __forceinline__ unsigned pk2(float lo, float hi) { f32x2_t v = {lo, hi}; bf16x2_t b = __builtin_convertvector(v, bf16x2_t); return __builtin_bit_cast(unsigned, b); }
__device__ __forceinline__ float bflo(unsigned w) { return __uint_as_float(w << 16); }
__device__ __forceinline__ float bfhi(unsigned w) { return __uint_as_float(w & 0xffff0000u); }
__device__ __forceinline__ float wave_sum(float v) {
#pragma unroll
    for (int o = 1; o < 64; o <<= 1) v += __shfl_xor(v, o);
    return v;
}

__device__ __forceinline__ void p0_transpose_item(const float* W, int K, int N, bf16* WT, LAS float* scr, int item, int lane, const float* gk) {
    const int nblk = N / 32, kb = item / nblk, nb = item % nblk, k0 = 64 * kb, n0 = 32 * nb;
    const int kl = lane >> 3, c4 = lane & 7;
    f32x4 v[8];
#pragma unroll
    for (int i = 0; i < 8; ++i) v[i] = *(const f32x4*)(W + (size_t)(k0 + 8 * i + kl) * N + n0 + 4 * c4);
#pragma unroll
    for (int i = 0; i < 8; ++i) { const float gv = gk ? gk[k0 + 8 * i + kl] : 1.f; LAS float* d = scr + (8 * i + kl) * 33 + 4 * c4; d[0] = v[i].x * gv; d[1] = v[i].y * gv; d[2] = v[i].z * gv; d[3] = v[i].w * gv; }
    asm volatile("s_waitcnt lgkmcnt(0)" ::: "memory");
    const int c = lane & 7;
#pragma unroll
    for (int j = 0; j < 4; ++j) { const int n = (lane >> 3) + 8 * j; const LAS float* s = scr + (8 * c) * 33 + n;
        u32x4 o; o.x = pk2(s[0 * 33], s[1 * 33]); o.y = pk2(s[2 * 33], s[3 * 33]); o.z = pk2(s[4 * 33], s[5 * 33]); o.w = pk2(s[6 * 33], s[7 * 33]);
        *(u32x4*)(WT + (size_t)(n0 + n) * K + k0 + 8 * c) = o; }
    asm volatile("s_waitcnt lgkmcnt(0)" ::: "memory");
}

template <int R> __device__ __forceinline__ void rms_rows_to_bf16(const float* x, float* rsout, bf16* out, int m0, int mstride, int lane) {
    f32x4 v[R][4]; float s[R];
#pragma unroll
    for (int r = 0; r < R; ++r)
#pragma unroll
        for (int j = 0; j < 4; ++j) v[r][j] = *((const f32x4*)(x + (size_t)(m0 + r * mstride) * DM) + lane + 64 * j);
#pragma unroll
    for (int r = 0; r < R; ++r) { float a = 0.f;
#pragma unroll
        for (int j = 0; j < 4; ++j) a += (v[r][j].x * v[r][j].x + v[r][j].y * v[r][j].y) + (v[r][j].z * v[r][j].z + v[r][j].w * v[r][j].w);
        s[r] = a; }
#pragma unroll
    for (int o = 1; o < 64; o <<= 1)
#pragma unroll
        for (int r = 0; r < R; ++r) s[r] += __shfl_xor(s[r], o);
#pragma unroll
    for (int r = 0; r < R; ++r) { if (lane == 0) rsout[m0 + r * mstride] = __builtin_amdgcn_rsqf(s[r] * (1.f / DM) + EPS);
        u32x2* o8 = (u32x2*)(out + (size_t)(m0 + r * mstride) * DM) + lane;
#pragma unroll
        for (int j = 0; j < 4; ++j) { u32x2 w; w.x = pk2(v[r][j].x, v[r][j].y); w.y = pk2(v[r][j].z, v[r][j].w); o8[64 * j] = w; } }
}

template <int R, bool XIN32, bool XOUT32> __device__ __forceinline__ void post_norm_rows(const bf16* mb, const void* xin, void* xout, const float* gpost, float* rsout, int m0, int mstride, int lane) {
    f32x4 xv[R][4]; u32x2 mw[R][4]; float s[R];
#pragma unroll
    for (int r = 0; r < R; ++r)
#pragma unroll
        for (int j = 0; j < 4; ++j) { const size_t ro = (size_t)(m0 + r * mstride) * DM; mw[r][j] = *((const u32x2*)(mb + ro) + lane + 64 * j);
            if (XIN32) xv[r][j] = *((const f32x4*)((const float*)xin + ro) + lane + 64 * j);
            else { const u32x2 w = *((const u32x2*)((const bf16*)xin + ro) + lane + 64 * j); xv[r][j] = (f32x4){bflo(w.x), bfhi(w.x), bflo(w.y), bfhi(w.y)}; } }
    f32x4 gg[4];
#pragma unroll
    for (int j = 0; j < 4; ++j) gg[j] = *((const f32x4*)gpost + lane + 64 * j);
#pragma unroll
    for (int r = 0; r < R; ++r) { float a = 0.f;
#pragma unroll
        for (int j = 0; j < 4; ++j) { const float a0 = bflo(mw[r][j].x), a1 = bfhi(mw[r][j].x), a2 = bflo(mw[r][j].y), a3 = bfhi(mw[r][j].y); a += (a0 * a0 + a1 * a1) + (a2 * a2 + a3 * a3); }
        s[r] = a; }
#pragma unroll
    for (int o = 1; o < 64; o <<= 1)
#pragma unroll
        for (int r = 0; r < R; ++r) s[r] += __shfl_xor(s[r], o);
#pragma unroll
    for (int r = 0; r < R; ++r) { const float rs = __builtin_amdgcn_rsqf(s[r] * (1.f / DM) + EPS); float a = 0.f; const size_t ro = (size_t)(m0 + r * mstride) * DM;
#pragma unroll
        for (int j = 0; j < 4; ++j) { const f32x4 mv = {bflo(mw[r][j].x), bfhi(mw[r][j].x), bflo(mw[r][j].y), bfhi(mw[r][j].y)};
            xv[r][j] = xv[r][j] + mv * rs * gg[j];
            if (XOUT32) *((f32x4*)((float*)xout + ro) + lane + 64 * j) = xv[r][j];
            else { u32x2 w; w.x = pk2(xv[r][j].x, xv[r][j].y); w.y = pk2(xv[r][j].z, xv[r][j].w); *((u32x2*)((bf16*)xout + ro) + lane + 64 * j) = w; }
            a += (xv[r][j].x * xv[r][j].x + xv[r][j].y * xv[r][j].y) + (xv[r][j].z * xv[r][j].z + xv[r][j].w * xv[r][j].w); }
        s[r] = a; }
    if (rsout) {
#pragma unroll
        for (int o = 1; o < 64; o <<= 1)
#pragma unroll
            for (int r = 0; r < R; ++r) s[r] += __shfl_xor(s[r], o);
#pragma unroll
        for (int r = 0; r < R; ++r) if (lane == 0) rsout[m0 + r * mstride] = __builtin_amdgcn_rsqf(s[r] * (1.f / DM) + EPS);
    }
}

constexpr int LRU_LDS_OFF = 98304;
constexpr int XB_LDS_OFF = 132096;
__device__ __forceinline__ float sigmoidf_(float x) { return __builtin_amdgcn_rcpf(1.0f + __builtin_amdgcn_exp2f(-1.4426950408889634f * x)); }
__device__ __forceinline__ float gelu_tanh(float g) { const float y2 = (2.0f * 0.7978845608028654f) * (g + 0.044715f * g * g * g); return g * sigmoidf_(y2); }

__device__ __forceinline__ void lru_unit(int unit, const bf16* Z, bf16* MIX, const float* conv_w, const float* conv_b, const float* w_r, const float* b_r,
                                         const float* w_i, const float* b_i, const float* lam, LAS unsigned char* lds) {
    const int qt = unit & 3, n = (unit >> 2) & 7, b = unit >> 5;
    int tid_ = threadIdx.x; asm volatile("" : "+v"(tid_));
    const int tid = tid_, lane = tid & 63, wid = __builtin_amdgcn_readfirstlane(tid >> 6), l15 = lane & 15, fq = lane >> 4;
    bf16x8 wd[4][2]; f32x4 cbv[4];
    bf16x8 wr[2], wi[2], wx[2];
#pragma unroll
    for (int ct = 0; ct < 4; ++ct) {
#pragma unroll
        for (int r = 0; r < 4; ++r) cbv[ct][r] = conv_b[64 * n + 16 * ct + 4 * fq + r];
#pragma unroll
        for (int ksp = 0; ksp < 2; ++ksp)
#pragma unroll
            for (int j = 0; j < 8; ++j) { const int tap = 2 * ksp + (fq >> 1), chl = 8 * (fq & 1) + j;
                wd[ct][ksp][j] = (chl == l15) ? (short)f2bf(conv_w[tap * LW + 64 * n + 16 * ct + chl]) : (short)0; }
    }
#pragma unroll
    for (int ks = 0; ks < 2; ++ks)
#pragma unroll
        for (int j = 0; j < 8; ++j) { const int sig = 16 * (2 * ks + (j >> 2)) + 4 * fq + (j & 3);
            wr[ks][j] = (short)f2bf(w_r[(size_t)(n * 64 + sig) * 64 + 16 * qt + l15]);
            wi[ks][j] = (short)f2bf(w_i[(size_t)(n * 64 + sig) * 64 + 16 * qt + l15]);
            wx[ks][j] = (sig == 16 * qt + l15) ? (short)0x3F80 : (short)0; }
    const int chan = 64 * n + 16 * qt + l15;
    const float br = b_r[chan], bi = b_i[chan], sp8 = -8.0f * log1pf(__expf(-lam[chan]));
    const bf16* Zb = Z + (size_t)b * SEQ * INW;
    bf16* Ob = MIX + (size_t)b * SEQ * DM + AW + chan;
    float hseg = 0.f;
    const bf16* Zx = Zb + 1536 + 64 * n + 8 * (fq & 1);
#define LRU_LOAD(dst, tbase) do { _Pragma("unroll") for (int ksp_ = 0; ksp_ < 2; ++ksp_) { int tt_ = (tbase) + l15 - 3 + 2 * ksp_ + (fq >> 1); tt_ = tt_ < 0 ? 0 : (tt_ > SEQ - 1 ? SEQ - 1 : tt_); \
        _Pragma("unroll") for (int ct_ = 0; ct_ < 4; ++ct_) dst[ct_][ksp_] = *(const u32x4*)(Zx + (size_t)tt_ * INW + 16 * ct_); } } while (0)
    u32x4 bufA[4][2], bufB[4][2];
    unsigned short grn[4][4];
    LRU_LOAD(bufA, wid * 64); LRU_LOAD(bufB, wid * 64 + 16);
#pragma unroll
    for (int mt = 0; mt < 4; ++mt)
#pragma unroll
        for (int r = 0; r < 4; ++r) grn[mt][r] = Zb[(size_t)(wid * 64 + 16 * mt + 4 * fq + r) * INW + 2048 + chan];
    for (int seg = 0; seg < 8; ++seg) {
        const int tw = seg * 512 + wid * 64;
        float Cel[4][4], Hel[4][4];
        unsigned short grv[4][4];
#pragma unroll
        for (int mt = 0; mt < 4; ++mt)
#pragma unroll
            for (int r = 0; r < 4; ++r) { grv[mt][r] = grn[mt][r]; const int tn = tw + 512 + 16 * mt + 4 * fq + r; grn[mt][r] = Zb[(size_t)(tn > SEQ - 1 ? SEQ - 1 : tn) * INW + 2048 + chan]; }
        float Cw = 1.f, Hw = 0.f;
#pragma unroll
        for (int mt = 0; mt < 4; ++mt) {
            const int t = tw + 16 * mt + l15;
            f32x4 accr = {0.f, 0.f, 0.f, 0.f}, acci = {0.f, 0.f, 0.f, 0.f}, accx = {0.f, 0.f, 0.f, 0.f};
            f32x4 cacc[4];
#pragma unroll
            for (int ct = 0; ct < 4; ++ct) {
                cacc[ct] = cbv[ct];
#pragma unroll
                for (int ksp = 0; ksp < 2; ++ksp) {
                    u32x4 v = (mt & 1) ? bufB[ct][ksp] : bufA[ct][ksp];
                    if ((tw + 16 * mt) == 0) { if (t - 3 + 2 * ksp + (fq >> 1) < 0) v = (u32x4){0u, 0u, 0u, 0u}; }
                    cacc[ct] = __builtin_amdgcn_mfma_f32_16x16x32_bf16(wd[ct][ksp], __builtin_bit_cast(bf16x8, v), cacc[ct], 0, 0, 0);
                }
            }
            { const int tb = (mt < 2) ? tw + 16 * (mt + 2) : tw + 512 + 16 * (mt - 2); if (mt & 1) LRU_LOAD(bufB, tb); else LRU_LOAD(bufA, tb); }
#pragma unroll
            for (int ks = 0; ks < 2; ++ks) {
                u32x4 ap; ap.x = pk2(cacc[2 * ks][0], cacc[2 * ks][1]); ap.y = pk2(cacc[2 * ks][2], cacc[2 * ks][3]);
                ap.z = pk2(cacc[2 * ks + 1][0], cacc[2 * ks + 1][1]); ap.w = pk2(cacc[2 * ks + 1][2], cacc[2 * ks + 1][3]);
                const bf16x8 a = __builtin_bit_cast(bf16x8, ap);
                accr = __builtin_amdgcn_mfma_f32_16x16x32_bf16(a, wr[ks], accr, 0, 0, 0);
                acci = __builtin_amdgcn_mfma_f32_16x16x32_bf16(a, wi[ks], acci, 0, 0, 0);
                accx = __builtin_amdgcn_mfma_f32_16x16x32_bf16(a, wx[ks], accx, 0, 0, 0);
            }
            float C[4], H[4];
#pragma unroll
            for (int r = 0; r < 4; ++r) {
                const float rg = sigmoidf_(accr[r] + br), ig = sigmoidf_(acci[r] + bi);
                const float la = sp8 * rg; const float a_ = __builtin_amdgcn_exp2f(1.4426950408889634f * la); const float mult = __builtin_amdgcn_sqrtf(fmaxf(1.0f - a_ * a_, 0.f));
                const float u_ = mult * ig * accx[r];
                if (r == 0) { C[0] = a_; H[0] = u_; } else { C[r] = a_ * C[r - 1]; H[r] = a_ * H[r - 1] + u_; }
            }
            float Ct = C[3], Ht = H[3];
            { const float Cp = __shfl_up(Ct, 16), Hp = __shfl_up(Ht, 16); if (fq >= 1) { Ht = Ct * Hp + Ht; Ct = Ct * Cp; } }
            { const float Cp = __shfl_up(Ct, 32), Hp = __shfl_up(Ht, 32); if (fq >= 2) { Ht = Ct * Hp + Ht; Ct = Ct * Cp; } }
            float Ce = __shfl_up(Ct, 16), He = __shfl_up(Ht, 16); if (fq == 0) { Ce = 1.f; He = 0.f; }
            const float Ctile = __shfl(Ct, 48 + l15), Htile = __shfl(Ht, 48 + l15);
            const float Cp = Cw * Ce, Hp = Ce * Hw + He;
#pragma unroll
            for (int r = 0; r < 4; ++r) { Cel[mt][r] = Cp * C[r]; Hel[mt][r] = C[r] * Hp + H[r]; }
            Hw = Ctile * Hw + Htile; Cw = Cw * Ctile;
        }
        LAS float* tot = (LAS float*)(lds + LRU_LDS_OFF) + (seg & 1) * 256;
        if (fq == 0) { tot[(wid * 16 + l15) * 2] = Cw; tot[(wid * 16 + l15) * 2 + 1] = Hw; }
        __syncthreads();
        float hin = hseg, hall = hseg;
#pragma unroll
        for (int w2 = 0; w2 < 8; ++w2) { const float c2 = tot[(w2 * 16 + l15) * 2], h2 = tot[(w2 * 16 + l15) * 2 + 1]; hall = c2 * hall + h2; if (w2 < wid) hin = hall; }
#pragma unroll
        for (int mt = 0; mt < 4; ++mt)
#pragma unroll
            for (int r = 0; r < 4; ++r) {
                const float hv = Cel[mt][r] * hin + Hel[mt][r];
                const float g = __uint_as_float((unsigned)grv[mt][r] << 16);
                Ob[(size_t)(tw + 16 * mt + 4 * fq + r) * DM] = (bf16)f2bf(hv * gelu_tanh(g));
            }
        hseg = hall;
    }
#undef LRU_LOAD
    __syncthreads();
}

constexpr int AT_PITCH = 160;
constexpr int AT_K = 0, AT_V = 384 * AT_PITCH;
constexpr int ATT_UNITS = NB * NH * 3 * 16;

struct AttPre { u32x4 k[6], v[6], q[4]; };
__device__ __forceinline__ void att_decode(int u, int& b, int& h, int& br, int& dsh, int& c, int& n2) {
    const int blk = u & 15, t = u >> 4; br = t % 3; const int bh = t / 3; h = bh & 7; b = bh >> 3; dsh = 2 * br; c = blk >> (4 - dsh); n2 = blk & ((16 >> dsh) - 1);
}
__device__ __forceinline__ void att_issue(int u, const bf16* Z, AttPre& P) {
    int b, h, br, dsh, c, n2; att_decode(u, b, h, br, dsh, c, n2);
    int tid_ = threadIdx.x; asm volatile("" : "+v"(tid_));
    const int tid = tid_, lane = tid & 63, wid = tid >> 6, l15 = lane & 15, fq = lane >> 4;
    const bf16* Zb = Z + (size_t)b * SEQ * INW + h * HD;
#pragma unroll
    for (int i = 0; i < 6; ++i) {
        const int id = tid + 512 * i, row = id >> 3, ch = id & 7; int tau = n2 * 256 - 128 + row; tau = tau < 0 ? 0 : tau;
        const bf16* p = Zb + (size_t)((tau << dsh) + c) * INW + ch * 8;
        P.k[i] = *(const u32x4*)(p + AW); P.v[i] = *(const u32x4*)(p + 2 * AW);
    }
#pragma unroll
    for (int blk = 0; blk < 2; ++blk) {
        const int posq = ((n2 * 256 + 128 * blk + 16 * wid + l15) << dsh) + c;
#pragma unroll
        for (int ks = 0; ks < 2; ++ks) P.q[2 * blk + ks] = *(const u32x4*)(Zb + (size_t)posq * INW + 32 * ks + 8 * fq);
    }
}
__device__ __forceinline__ void att_stage(const AttPre& P, LAS unsigned char* lds) {
    int tid_ = threadIdx.x; asm volatile("" : "+v"(tid_)); const int tid = tid_;
#pragma unroll
    for (int i = 0; i < 6; ++i) { const int id = tid + 512 * i, row = id >> 3, ch = id & 7;
        *(LAS u32x4*)(lds + AT_K + row * AT_PITCH + ch * 16) = P.k[i]; *(LAS u32x4*)(lds + AT_V + row * AT_PITCH + ch * 16) = P.v[i]; }
}
__device__ __forceinline__ s16x4 vtr(const LAS unsigned char* p) { return __builtin_bit_cast(s16x4, __builtin_amdgcn_ds_read_tr16_b64_v4i16((LAS s16x4*)p)); }

__device__ __forceinline__ void att_compute(int u, int blk, const u32x4& qf0, const u32x4& qf1, unsigned char* ws, float* LSE, LAS unsigned char* lds) {
    int b, h, br, dsh, c, n2; att_decode(u, b, h, br, dsh, c, n2); const int n = 2 * n2 + blk;
    int tid_ = threadIdx.x; asm volatile("" : "+v"(tid_));
    const int tid = tid_, lane = tid & 63, wid = __builtin_amdgcn_readfirstlane(tid >> 6), l15 = lane & 15, fq = lane >> 4;
    const bf16x8 q0 = __builtin_bit_cast(bf16x8, qf0), q1 = __builtin_bit_cast(bf16x8, qf1);
    f32x4 s[9];
    const LAS unsigned char* kb = lds + AT_K + (128 * blk + 16 * wid + l15) * AT_PITCH + fq * 16;
#pragma unroll
    for (int j = 0; j < 9; ++j) {
        const bf16x8 a0 = *(const LAS bf16x8*)(kb + j * 16 * AT_PITCH), a1 = *(const LAS bf16x8*)(kb + j * 16 * AT_PITCH + 64);
        f32x4 acc = {0.f, 0.f, 0.f, 0.f};
        acc = __builtin_amdgcn_mfma_f32_16x16x32_bf16(a0, q0, acc, 0, 0, 0);
        acc = __builtin_amdgcn_mfma_f32_16x16x32_bf16(a1, q1, acc, 0, 0, 0);
        s[j] = acc;
    }
    const float NEG = -INFINITY;
#pragma unroll
    for (int r = 0; r < 4; ++r) { const int dlt = 4 * fq + r - l15; if (dlt < 0) s[0][r] = NEG; if (dlt > 0) s[8][r] = NEG; }
    if (n == 0) {
#pragma unroll
        for (int j = 0; j < 8; ++j) if (wid + j < 8) s[j] = (f32x4){NEG, NEG, NEG, NEG};
    }
    float m = NEG;
#pragma unroll
    for (int j = 0; j < 9; ++j) m = fmaxf(m, fmaxf(fmaxf(s[j][0], s[j][1]), fmaxf(s[j][2], s[j][3])));
    m = fmaxf(m, __shfl_xor(m, 16)); m = fmaxf(m, __shfl_xor(m, 32));
    float l = 0.f;
#pragma unroll
    for (int j = 0; j < 9; ++j)
#pragma unroll
        for (int r = 0; r < 4; ++r) { const float p = __builtin_amdgcn_exp2f(s[j][r] - m); s[j][r] = p; l += p; }
    l += __shfl_xor(l, 16); l += __shfl_xor(l, 32);
    bf16x8 pb[5];
#pragma unroll
    for (int pr = 0; pr < 5; ++pr) {
        u32x4 w; w.x = pk2(s[2 * pr][0], s[2 * pr][1]); w.y = pk2(s[2 * pr][2], s[2 * pr][3]);
        if (pr < 4) { w.z = pk2(s[2 * pr + 1][0], s[2 * pr + 1][1]); w.w = pk2(s[2 * pr + 1][2], s[2 * pr + 1][3]); } else { w.z = 0u; w.w = 0u; }
        pb[pr] = __builtin_bit_cast(bf16x8, w);
    }
    const LAS unsigned char* vb = lds + AT_V + (128 * blk + 16 * wid + 4 * fq + (l15 >> 2)) * AT_PITCH + (l15 & 3) * 8;
    f32x4 o[4];
#pragma unroll
    for (int dt = 0; dt < 4; ++dt) {
        f32x4 acc = {0.f, 0.f, 0.f, 0.f};
#pragma unroll
        for (int pr = 0; pr < 5; ++pr) {
            const s16x4 lo = vtr(vb + (2 * pr) * 16 * AT_PITCH + dt * 32);
            s16x4 hi = {0, 0, 0, 0};
            if (pr < 4) hi = vtr(vb + (2 * pr + 1) * 16 * AT_PITCH + dt * 32);
            const bf16x8 a = {lo[0], lo[1], lo[2], lo[3], hi[0], hi[1], hi[2], hi[3]};
            acc = __builtin_amdgcn_mfma_f32_16x16x32_bf16(a, pb[pr], acc, 0, 0, 0);
        }
        o[dt] = acc;
    }
    const float inv = __builtin_amdgcn_rcpf(l);
    const int posq = ((n * 128 + 16 * wid + l15) << dsh) + c;
    const size_t row = (size_t)b * SEQ + posq;
    bf16* op = op_base(ws, br) + row * AW + h * HD + 4 * fq;
#pragma unroll
    for (int dt = 0; dt < 4; ++dt) { u32x2 w; w.x = pk2(o[dt][0] * inv, o[dt][1] * inv); w.y = pk2(o[dt][2] * inv, o[dt][3] * inv); *(u32x2*)(op + 16 * dt) = w; }
    if (fq == 0) LSE[((size_t)br * M + row) * NH + h] = m + __builtin_amdgcn_logf(l);
}

__device__ __forceinline__ void att_combine(unsigned char* ws, const float* LSE, bf16* MIX, int gtid, int gthreads) {
    for (int id = gtid; id < M * 64; id += gthreads) {
        const int row = id >> 6, ch = id & 63, h = ch >> 3;
        float L[3];
#pragma unroll
        for (int p = 0; p < 3; ++p) L[p] = LSE[((size_t)p * M + row) * NH + h];
        const float mx = fmaxf(L[0], fmaxf(L[1], L[2]));
        float w[3]; float sw = 0.f;
#pragma unroll
        for (int p = 0; p < 3; ++p) { w[p] = __builtin_amdgcn_exp2f(L[p] - mx); sw += w[p]; }
        const float isw = __builtin_amdgcn_rcpf(sw);
        float acc[8] = {0.f, 0.f, 0.f, 0.f, 0.f, 0.f, 0.f, 0.f};
#pragma unroll
        for (int p = 0; p < 3; ++p) { const u32x4 v = *(const u32x4*)(op_base(ws, p) + (size_t)row * AW + ch * 8); const float ww = w[p] * isw;
            acc[0] += ww * bflo(v.x); acc[1] += ww * bfhi(v.x); acc[2] += ww * bflo(v.y); acc[3] += ww * bfhi(v.y);
            acc[4] += ww * bflo(v.z); acc[5] += ww * bfhi(v.z); acc[6] += ww * bflo(v.w); acc[7] += ww * bfhi(v.w); }
        u32x4 o; o.x = pk2(acc[0], acc[1]); o.y = pk2(acc[2], acc[3]); o.z = pk2(acc[4], acc[5]); o.w = pk2(acc[6], acc[7]);
        *(u32x4*)(MIX + (size_t)row * DM + ch * 8) = o;
    }
}

#define XB_TMO      128
#define XB_XCNT(j)  (256  + 64 * (j))
#define XB_XSUB(j)  (1280 + 64 * (j))
#define XB_XGEN(j)  (2304 + 64 * (j))
#define XB_TOP      3328
#define XB_TOPGEN   3392
#define XCD_BAR_WORDS 3456
#define XB_SPIN_CAP (1u << 18)

__device__ __forceinline__ unsigned xb_ld(unsigned* p)              { return __hip_atomic_load(p, __ATOMIC_RELAXED, __HIP_MEMORY_SCOPE_AGENT); }
__device__ __forceinline__ unsigned xb_add(unsigned* p, unsigned v) { return __hip_atomic_fetch_add(p, v, __ATOMIC_RELAXED, __HIP_MEMORY_SCOPE_AGENT); }
__device__ __forceinline__ unsigned xb_xcc_id() { return (unsigned)__builtin_amdgcn_s_getreg((3 << 11) | 20) & 0xFu; }
#define XB_SPIN(cond, bar) do { unsigned _sp = 0; while (cond) { __builtin_amdgcn_s_sleep(1); \
    if ((++_sp & 255u) == 0u) { if (xb_ld(&(bar)[XB_TMO])) break; if (_sp > XB_SPIN_CAP) { atomicAdd(&(bar)[XB_TMO], 1u); break; } } } } while (0)

struct XcdBarrier {
    unsigned* bar; unsigned x;
    volatile LAS unsigned* st;
};

__device__ __forceinline__ XcdBarrier xcd_barrier_post(unsigned* bar, volatile LAS unsigned* st) {
    XcdBarrier b; b.bar = bar; b.x = xb_xcc_id(); b.st = st;
    if (threadIdx.x == 0) (void)xb_add(&bar[XB_XCNT(b.x)], 1u);
    return b;
}
__device__ __forceinline__ void xcd_barrier_complete(unsigned* bar, unsigned x, unsigned& nloc, unsigned& nx) {
    const unsigned G = gridDim.x * gridDim.y * gridDim.z;
    unsigned sum, cnt, mine, sp = 0u;
    for (;;) {
        sum = 0u; cnt = 0u; mine = 0u;
#pragma unroll
        for (unsigned j = 0; j < 16; ++j) { const unsigned c = xb_ld(&bar[XB_XCNT(j)]); sum += c; cnt += (c > 0u) ? 1u : 0u; mine = (j == x) ? c : mine; }
        if (sum == G) break;
        __builtin_amdgcn_s_sleep(1);
        if ((++sp & 255u) == 0u) { if (xb_ld(&bar[XB_TMO])) break; if (sp > XB_SPIN_CAP) { atomicAdd(&bar[XB_TMO], 1u); break; } }
    }
    nloc = mine > 0u ? mine : 1u; nx = cnt > 0u ? cnt : 1u;
}

__device__ __forceinline__ void xcd_barrier(const XcdBarrier& b) {
    asm volatile("s_waitcnt vmcnt(0)" ::: "memory");
    __syncthreads();
    if (threadIdx.x == 0) {
        unsigned* bar = b.bar;
        __builtin_amdgcn_s_waitcnt(0);
        unsigned nloc = b.st[0], nx = b.st[1];
        if (nloc == 0u) { xcd_barrier_complete(bar, b.x, nloc, nx); b.st[0] = nloc; b.st[1] = nx; }
        const unsigned old = xb_add(&bar[XB_XSUB(b.x)], 1u);
        const unsigned gen = old / nloc;
        if (old + 1u == (gen + 1u) * nloc) {
            __builtin_amdgcn_fence(__ATOMIC_RELEASE, "agent");
            asm volatile("s_waitcnt vmcnt(0)" ::: "memory");
            const unsigned og = xb_add(&bar[XB_TOP], 1u);
            const unsigned tg = og / nx;
            if (og + 1u == (tg + 1u) * nx) xb_add(&bar[XB_TOPGEN], 1u);
            else XB_SPIN(xb_ld(&bar[XB_TOPGEN]) == tg, bar);
            __builtin_amdgcn_fence(__ATOMIC_ACQUIRE, "agent");
            xb_add(&bar[XB_XGEN(b.x)], 1u);
            asm volatile("s_waitcnt vmcnt(0)" ::: "memory");
        } else {
            XB_SPIN(xb_ld(&bar[XB_XGEN(b.x)]) == gen, bar);
            __builtin_amdgcn_fence(__ATOMIC_ACQUIRE, "agent");
            asm volatile("s_waitcnt vmcnt(0)" ::: "memory");
        }
    }
    __syncthreads();
}


constexpr int FX_CNT_WORD = 16384;
struct RowStats {
    float* slots;
    unsigned* cnt;
    __device__ __forceinline__ void run(const pg8::f32x4 (&v)[2][2][4][2], const pg8::Unit& u, int wr, int wc, int fr, int fq, LAS unsigned char* lds, int wid, int lane, const float* rprev) const {
        LAS float* P = (LAS float*)lds;
        LAS float* S = (LAS float*)(lds + 8192);
#pragma unroll
        for (int ai = 0; ai < 2; ++ai)
#pragma unroll
            for (int mm = 0; mm < 4; ++mm) {
                float s = 0.f;
#pragma unroll
                for (int bj = 0; bj < 2; ++bj)
#pragma unroll
                    for (int n = 0; n < 2; ++n) { const pg8::f32x4 x = v[ai][bj][mm][n]; s += (x[0] * x[0] + x[1] * x[1]) + (x[2] * x[2] + x[3] * x[3]); }
                s += __shfl_xor(s, 16); s += __shfl_xor(s, 32);
                if (fq == 0) P[(ai * 128 + wr * 64 + mm * 16 + fr) * 4 + wc] = s;
            }
        asm volatile("s_waitcnt lgkmcnt(0)" ::: "memory"); __builtin_amdgcn_s_barrier(); asm volatile("" ::: "memory");
        const int row = wid * 32 + (lane & 31);
        const float pr = rprev[u.pm * 256 + row];
        if (lane < 32) {
            const float t = (P[row * 4 + 0] + P[row * 4 + 1]) + (P[row * 4 + 2] + P[row * 4 + 3]);
            __hip_atomic_store(slots + ((size_t)(u.pm * 256 + row) * 4 + u.pn), t, __ATOMIC_RELAXED, __HIP_MEMORY_SCOPE_AGENT);
        }
        asm volatile("s_waitcnt vmcnt(0)" ::: "memory");
        if (lane == 0) __hip_atomic_fetch_add(cnt + 64 * u.pm, 1u, __ATOMIC_RELAXED, __HIP_MEMORY_SCOPE_AGENT);
        if (wid == 0) { unsigned sp = 0;
            while ((unsigned)__builtin_amdgcn_readfirstlane(__hip_atomic_load(cnt + 64 * u.pm, __ATOMIC_RELAXED, __HIP_MEMORY_SCOPE_AGENT)) < 32u && ++sp < (1u << 22)) __builtin_amdgcn_s_sleep(1); }
        asm volatile("s_waitcnt vmcnt(0) lgkmcnt(0)" ::: "memory"); __builtin_amdgcn_s_barrier(); asm volatile("" ::: "memory");
        if (lane < 32) {
            const float* sl = slots + (size_t)(u.pm * 256 + row) * 4; float t = 0.f;
#pragma unroll
            for (int k = 0; k < 4; ++k) t += __hip_atomic_load(sl + k, __ATOMIC_RELAXED, __HIP_MEMORY_SCOPE_AGENT);
            const float p2 = pr * pr; S[row] = t * (1.f / DM) + EPS * __builtin_amdgcn_rcpf(p2 * p2);
        }
        asm volatile("s_waitcnt vmcnt(0) lgkmcnt(0)" ::: "memory"); __builtin_amdgcn_s_barrier(); asm volatile("" ::: "memory");
    }
};
struct EpiRmsRes {
    static constexpr bool PERM = true, AFTER_DRAIN = true;
    const void* xin; void* xout; const float* gpost; float* rsout; RowStats st1, st2; int xin32, last; const float* rsprev; const float* ones;
    __device__ __forceinline__ void fused(pg8::f32x4 (&acc)[2][2][4][2], const pg8::Unit& u, int wr, int wc, int fr, int fq, LAS unsigned char* lds, int wid, int lane) const {
        const LAS float* S = (const LAS float*)(lds + 8192);
        const int col0 = u.pn * 256 + wc * 64 + 8 * fq;
        u32x4 xpre[2][4][2];
        if (!xin32) {
#pragma unroll
            for (int ai = 0; ai < 2; ++ai)
#pragma unroll
                for (int mm = 0; mm < 4; ++mm) { const size_t off = (size_t)(u.pm * 256 + ai * 128 + wr * 64 + mm * 16 + fr) * DM + col0;
#pragma unroll
                    for (int bj = 0; bj < 2; ++bj) xpre[ai][mm][bj] = *(const u32x4*)((const bf16*)xin + off + bj * 32); }
        }
        st1.run(acc, u, wr, wc, fr, fq, lds, wid, lane, rsprev);
        pg8::f32x4 gv[2][2];
#pragma unroll
        for (int bj = 0; bj < 2; ++bj)
#pragma unroll
            for (int n = 0; n < 2; ++n) gv[bj][n] = *(const pg8::f32x4*)(gpost + col0 + bj * 32 + n * 4);
#pragma unroll
        for (int ai = 0; ai < 2; ++ai)
#pragma unroll
            for (int mm = 0; mm < 4; ++mm) {
                const int r = ai * 128 + wr * 64 + mm * 16 + fr; const float rs = __builtin_amdgcn_rsqf(S[r]);
                const size_t off = (size_t)(u.pm * 256 + r) * DM + col0;
#pragma unroll
                for (int bj = 0; bj < 2; ++bj) {
                    pg8::f32x4 xa, xb;
                    if (xin32) { xa = *(const pg8::f32x4*)((const float*)xin + off + bj * 32); xb = *(const pg8::f32x4*)((const float*)xin + off + bj * 32 + 4); }
                    else { const u32x4 w = xpre[ai][mm][bj]; xa = (pg8::f32x4){bflo(w.x), bfhi(w.x), bflo(w.y), bfhi(w.y)}; xb = (pg8::f32x4){bflo(w.z), bfhi(w.z), bflo(w.w), bfhi(w.w)}; }
                    const pg8::f32x4 ya = xa + acc[ai][bj][mm][0] * rs * gv[bj][0], yb = xb + acc[ai][bj][mm][1] * rs * gv[bj][1];
                    acc[ai][bj][mm][0] = ya; acc[ai][bj][mm][1] = yb;
                    if (last) { *(pg8::f32x4*)((float*)xout + off + bj * 32) = ya; *(pg8::f32x4*)((float*)xout + off + bj * 32 + 4) = yb; }
                    else { u32x4 w; w.x = pk2(ya[0], ya[1]); w.y = pk2(ya[2], ya[3]); w.z = pk2(yb[0], yb[1]); w.w = pk2(yb[2], yb[3]); *(u32x4*)((bf16*)xout + off + bj * 32) = w; }
                }
                if (mm & 1) asm volatile("" ::: "memory");
            }
        if (!last) {
            st2.run(acc, u, wr, wc, fr, fq, lds, wid, lane, ones);
            if (u.pn == 0 && wc == 0 && fq == 0) {
#pragma unroll
                for (int ai = 0; ai < 2; ++ai)
#pragma unroll
                    for (int mm = 0; mm < 4; ++mm) { const int r = ai * 128 + wr * 64 + mm * 16 + fr; rsout[u.pm * 256 + r] = __builtin_amdgcn_rsqf(S[r]); }
            }
        }
        asm volatile("s_waitcnt lgkmcnt(0)" ::: "memory"); __builtin_amdgcn_s_barrier(); asm volatile("" ::: "memory");
    }
};
struct OneUnit {
    pg8::StaticOrder base; int round;
    __device__ __forceinline__ bool next(int i, pg8::Unit& u) const { return i == 0 && base.next(round, u); }
    __device__ __forceinline__ void a_ready(const pg8::Unit&) const {}
    __device__ __forceinline__ void done(const pg8::Unit&) const {}
};

#ifndef REP_SYNC
#define REP_SYNC 1
#endif
#define GSYNC() do { for (int rs_ = 0; rs_ < REP_SYNC; ++rs_) xcd_barrier(xbar); } while (0)
struct Args { const float* in[16]; float* out; unsigned char* ws; };

__global__ void __launch_bounds__(NWAVES * 64, 2) mega_fwd(Args args) {
    extern __shared__ __attribute__((aligned(16))) unsigned char lds_raw[];
    cg::grid_group grid = cg::this_grid();
    LAS unsigned char* lds = (LAS unsigned char*)lds_raw;
    const int tid = threadIdx.x, lane = tid & 63, wave = __builtin_amdgcn_readfirstlane(tid >> 6);
    const int G = gridDim.x, bx = blockIdx.x;
    const int gw = bx * NWAVES + wave, NGW = G * NWAVES;
    unsigned char* ws = args.ws;
    const float* x_in = args.in[0];
    float* xres = args.out;
    bf16* Hb = (bf16*)(ws + WS_H); bf16* MB = (bf16*)(ws + WS_MB); bf16* XR = (bf16*)(ws + WS_XR); float* LSE = (float*)(ws + WS_LSE);
    float* RS1 = (float*)(ws + WS_RS1); float* RS2 = (float*)(ws + WS_RS2); float* RS0 = (float*)(ws + WS_RS1 + 524288);
    bf16* Zb = (bf16*)(ws + WS_Z); bf16* MIX = (bf16*)(ws + WS_MIX); bf16* AB = (bf16*)(ws + WS_A);

    unsigned* barw = (unsigned*)(ws + WS_CTL);
    if (bx == 0) for (int i = tid; i < XCD_BAR_WORDS; i += NWAVES * 64) __hip_atomic_store(barw + i, 0u, __ATOMIC_RELAXED, __HIP_MEMORY_SCOPE_AGENT);
    if (tid < 2) ((volatile LAS unsigned*)(lds + XB_LDS_OFF))[tid] = 0u;
    for (int i = bx * (NWAVES * 64) + tid; i < 16 * 128 * 64; i += G * NWAVES * 64) __hip_atomic_store(barw + FX_CNT_WORD + i, 0u, __ATOMIC_RELAXED, __HIP_MEMORY_SCOPE_AGENT);
#ifndef REP_P0
#define REP_P0 1
#endif
    for (int rep_ = 0; rep_ < REP_P0; ++rep_) {
        LAS float* scr = (LAS float*)(lds + wave * 16384);
        constexpr int I_IN = (DM / 64) * (INW / 32), I_OUT = (DM / 64) * (DM / 32), I_F1 = (DM / 64) * (DFF / 32), I_F2 = (DFF / 64) * (DM / 32);
        constexpr int I_LAYER = I_IN + I_OUT + I_F1 + I_F2;
        for (int it = gw; it < DEPTH * I_LAYER; it += NGW) {
            const int l = it / I_LAYER; int r = it % I_LAYER;
            if (r < I_IN) { p0_transpose_item(args.in[5] + (size_t)l * DM * INW, DM, INW, (bf16*)(ws + WS_WIN) + (size_t)l * INW * DM, scr, r, lane, args.in[1] + l * DM); continue; } r -= I_IN;
            if (r < I_OUT) { p0_transpose_item(args.in[13] + (size_t)l * DM * DM, DM, DM, (bf16*)(ws + WS_WOUT) + (size_t)l * DM * DM, scr, r, lane, nullptr); continue; } r -= I_OUT;
            if (r < I_F1) { p0_transpose_item(args.in[14] + (size_t)l * DM * DFF, DM, DFF, (bf16*)(ws + WS_WFF1) + (size_t)l * DFF * DM, scr, r, lane, args.in[3] + l * DM); continue; } r -= I_F1;
            p0_transpose_item(args.in[15] + (size_t)l * DFF * DM, DFF, DM, (bf16*)(ws + WS_WFF2) + (size_t)l * DM * DFF, scr, r, lane, nullptr);
        }
        for (int i = bx * (NWAVES * 64) + tid; i < M; i += G * NWAVES * 64) RS0[i] = 1.0f;
        if (M % (4 * NGW) == 0) { for (int m = gw; m < M; m += 4 * NGW) rms_rows_to_bf16<4>(x_in, RS1, XR, m, NGW, lane); }
        else { for (int m = gw; m < M; m += NGW) rms_rows_to_bf16<1>(x_in, RS1, XR, m, NGW, lane); }
    }
    __syncthreads();
    grid.sync();
    XcdBarrier xbar = xcd_barrier_post(barw, (volatile LAS unsigned*)(lds + XB_LDS_OFF));

#ifdef PROBE_IDLE
    if (1) { const unsigned long long t0 = __builtin_amdgcn_s_memrealtime(); while (__builtin_amdgcn_s_memrealtime() - t0 < 50000ull) __builtin_amdgcn_s_sleep(64); }
#endif
    for (int l = 0; l < DEPTH; ++l) {
        {
            pg8::Gemm g{XR, (const bf16*)(ws + WS_WIN) + (size_t)l * INW * DM, M, INW, DM}; pg8::StaticOrder S; S.init(M, INW, G, bx);
            pg8::EpiBf16<0> E{Zb, INW, nullptr, AW, (size_t)AW, QSCALE, RS1, lds + XEPI_LDS_OFF};
            pg8::gemm_phase<pg8::EpiBf16<0>, pg8::StaticOrder, PG8_ALIGN, PG8_SP2>(lds, g, S, E);
        }
        GSYNC();
#ifndef REP_MIX
#define REP_MIX 1
#endif
        for (int rep_ = 0; rep_ < REP_MIX; ++rep_) {
#ifndef REP_LRU
#define REP_LRU 1
#endif
            for (int rl_ = 0; rl_ < REP_LRU; ++rl_)
            for (int u0 = bx; u0 < NB * 8 * 4; u0 += G) { const int u = ((G & 7) == 0 && G == NB * 8 * 4) ? (u0 & 7) * (G >> 3) + (u0 >> 3) : u0;
                lru_unit(u, Zb, MIX, args.in[6] + (size_t)l * 4 * LW, args.in[7] + (size_t)l * LW, args.in[8] + (size_t)l * 8 * 64 * 64, args.in[9] + (size_t)l * LW,
                         args.in[10] + (size_t)l * 8 * 64 * 64, args.in[11] + (size_t)l * LW, args.in[12] + (size_t)l * LW, lds); }
            AttPre P = {};
#define ATT_UIDX(k) (((((k) * (G >> 3) + (bx >> 3)) / 48) * 8 + (bx & 7)) * 48 + (((k) * (G >> 3) + (bx >> 3)) % 48))
            const int nk = ((G & 7) == 0 && ATT_UNITS % G == 0) ? ATT_UNITS / G : 0;
            int u = nk ? ATT_UIDX(0) : bx;
            if (u < ATT_UNITS) att_issue(u, Zb, P);
            for (int k = 0; u < ATT_UNITS; ++k) {
                const int unext = nk ? ((k + 1 < nk) ? ATT_UIDX(k + 1) : ATT_UNITS) : u + G;
                __syncthreads();
                att_stage(P, lds);
                const u32x4 qa0 = P.q[0], qa1 = P.q[1], qb0 = P.q[2], qb1 = P.q[3];
                __syncthreads();
                if (unext < ATT_UNITS) att_issue(unext, Zb, P);
                att_compute(u, 0, qa0, qa1, ws, LSE, lds);
                att_compute(u, 1, qb0, qb1, ws, LSE, lds);
                u = unext;
            }
#undef ATT_UIDX
        }
        GSYNC();
#ifndef REP_CMB
#define REP_CMB 1
#endif
        for (int rc_ = 0; rc_ < REP_CMB; ++rc_) { int t_ = threadIdx.x; asm volatile("" : "+v"(t_)); att_combine(ws, LSE, MIX, bx * (NWAVES * 64) + t_, G * NWAVES * 64); }
        GSYNC();
        for (int rnd = 0; rnd < 2; ++rnd) {
            pg8::Gemm g{MIX, (const bf16*)(ws + WS_WOUT) + (size_t)l * DM * DM, M, DM, DM}; OneUnit S; S.base.init(M, DM, G, bx); S.round = rnd;
            unsigned* cb = barw + FX_CNT_WORD + ((l * 2 + 0) * 2) * 128 * 64;
            EpiRmsRes E{(l == 0) ? (const void*)x_in : (const void*)XR, (void*)XR, args.in[2] + l * DM, RS2, RowStats{(float*)(ws + WS_FX1), cb}, RowStats{(float*)(ws + WS_FX2), cb + 128 * 64}, (l == 0) ? 1 : 0, 0, (const float*)RS0, (const float*)RS0};
            pg8::gemm_phase<EpiRmsRes, OneUnit, false, PG8_SP2>(lds, g, S, E);
        }
        GSYNC();
#ifndef REP_G3
#define REP_G3 1
#endif
        for (int rep_ = 0; rep_ < REP_G3; ++rep_) {
            pg8::Gemm g{XR, (const bf16*)(ws + WS_WFF1) + (size_t)l * DFF * DM, M, DFF, DM}; pg8::StaticOrder S; S.init(M, DFF, G, bx);
            pg8::EpiBf16<2> E{AB, DFF, nullptr, 0, 0, 1.f, nullptr, lds + XEPI_LDS_OFF};
            pg8::gemm_phase<pg8::EpiBf16<2>, pg8::StaticOrder, PG8_ALIGN, PG8_SP2>(lds, g, S, E);
        }
        GSYNC();
        for (int rnd = 0; rnd < 2; ++rnd) {
            pg8::Gemm g{AB, (const bf16*)(ws + WS_WFF2) + (size_t)l * DM * DFF, M, DM, DFF}; OneUnit S; S.base.init(M, DM, G, bx); S.round = rnd;
            unsigned* cb = barw + FX_CNT_WORD + ((l * 2 + 1) * 2) * 128 * 64;
            const int lastl = (l + 1 == DEPTH) ? 1 : 0;
            EpiRmsRes E{(const void*)XR, lastl ? (void*)xres : (void*)XR, args.in[4] + l * DM, RS1, RowStats{(float*)(ws + WS_FX1), cb}, RowStats{(float*)(ws + WS_FX2), cb + 128 * 64}, 0, lastl, (const float*)RS2, (const float*)RS0};
            pg8::gemm_phase<EpiRmsRes, OneUnit, false, PG8_SP2>(lds, g, S, E);
        }
        if (l + 1 < DEPTH) GSYNC();
    }
}

extern "C" void kernel_launch(void* const* d_in, const int* in_sizes, int n_in, void* d_out, int out_size, void* d_ws, size_t ws_size, hipStream_t stream) {
    static int grid = 0;
    if (grid == 0) {
        if (n_in != 16 || in_sizes[0] != M * DM || out_size != M * DM || ws_size < WS_END) { fprintf(stderr, "kernel_launch: unexpected shapes (n_in %d, in0 %d, out %d, ws %zu); nothing launched\n", n_in, n_in > 0 ? in_sizes[0] : -1, out_size, ws_size); grid = -1; return; }
        int dev = 0, cus = 0, per_cu = 0;
        if (hipGetDevice(&dev) != hipSuccess || hipDeviceGetAttribute(&cus, hipDeviceAttributeMultiprocessorCount, dev) != hipSuccess) { grid = -1; return; }
        if (hipFuncSetAttribute((const void*)mega_fwd, hipFuncAttributeMaxDynamicSharedMemorySize, LDS_BYTES) != hipSuccess) { fprintf(stderr, "kernel_launch: hipFuncSetAttribute failed\n"); grid = -1; return; }
        if (hipOccupancyMaxActiveBlocksPerMultiprocessor(&per_cu, (const void*)mega_fwd, NWAVES * 64, LDS_BYTES) != hipSuccess || per_cu < 1) { fprintf(stderr, "kernel_launch: occupancy query says %d\n", per_cu); per_cu = 1; }
        (void)hipGetLastError();
        grid = cus * per_cu;
    }
    if (grid < 0) return;
    Args a{};
    for (int i = 0; i < 16; ++i) a.in[i] = (const float*)d_in[i];
    a.out = (float*)d_out; a.ws = (unsigned char*)d_ws;
    void* kargs[] = {&a};
    hipError_t e = hipLaunchCooperativeKernel((const void*)mega_fwd, dim3(grid), dim3(NWAVES * 64), kargs, LDS_BYTES, stream);
    if (e != hipSuccess) fprintf(stderr, "kernel_launch: cooperative launch failed: %s (grid %d)\n", hipGetErrorString(e), grid);
}
```

```cpp
#include <hip/hip_runtime.h>
#include <hip/hip_cooperative_groups.h>
#include <cstdio>
#include <cstdint>
namespace cg = cooperative_groups;
namespace pg8 {
#define PG8_LAS __attribute__((address_space(3)))
typedef unsigned short bf16_t;
typedef short bf16x8 __attribute__((ext_vector_type(8)));
typedef float f32x4 __attribute__((ext_vector_type(4)));
typedef unsigned u32x4 __attribute__((ext_vector_type(4)));
constexpr int BM = 256, BK = 64, HALF = 128, HTB = HALF * BK * 2  , STAGE_BYTES = 8 * HTB, NXCD = 8, WGM = 8;

__host__ __device__ __forceinline__ int lds_byte(int r, int c) { const int st = (r >> 4) * 2 + (c >> 5), rr = r & 15, cc = c & 31, ob = rr * 64 + cc * 2; return st * 1024 + (ob ^ (((ob >> 9) & 1) << 5)); }
__host__ __device__ __forceinline__ void stage_rc(int b, int& R, int& C) { const int st = b / 1024, sb = b % 1024, swz = sb ^ (((sb >> 9) & 1) << 5); R = (st >> 1) * 16 + swz / 64; C = (st & 1) * 32 + (swz % 64) / 2; }
__host__ __device__ __forceinline__ int perm32(int rho) { const int n = rho >> 4, i = rho & 15; return 8 * (i >> 2) + 4 * n + (i & 3); }

struct Unit { int pm, pn; };
struct Gemm { const bf16_t* A; const bf16_t* Bt; int M, N, K; };

struct StaticOrder {
    int nM, nN, nwg, G, c;
    __host__ __device__ void init(int M, int N, int G_, int c_) { nM = M / BM; nN = N / BM; nwg = nM * nN; G = G_; c = c_; }
    __host__ __device__ bool next(int i, Unit& u) const {
        const long L = (long)i * G + c; if (L >= nwg) return false;
        int wgid = (int)L; { const int q = nwg / NXCD, r = nwg % NXCD, xcd = wgid % NXCD, off = wgid / NXCD; wgid = (xcd < r ? xcd * (q + 1) : r * (q + 1) + (xcd - r) * q) + off; }
        const int nig = WGM * nN, gid = wgid / nig, fm = gid * WGM, gsz = (nM - fm) < WGM ? (nM - fm) : WGM;
        u.pm = fm + ((wgid % nig) % gsz); u.pn = (wgid % nig) / gsz; return true;
    }
    __device__ __forceinline__ void a_ready(const Unit&) const {}
    __device__ __forceinline__ void done(const Unit&) const {}
};

__device__ __forceinline__ unsigned cvt_pk_bf16(float lo, float hi) { unsigned r; asm volatile("v_cvt_pk_bf16_f32 %0, %1, %2" : "=v"(r) : "v"(lo), "v"(hi)); return r; }
typedef float f32x2 __attribute__((ext_vector_type(2)));
__device__ __forceinline__ f32x2 gelu_pk(f32x2 v) {
    const f32x2 av = __builtin_elementwise_abs(v), d = av * 0.2316418882f + 1.0f;
    f32x2 t; t.x = __builtin_amdgcn_rcpf(d.x); t.y = __builtin_amdgcn_rcpf(d.y);
    f32x2 q = t * 0.5307027145f + (-0.7265760135f); q = q * t + 0.7107068705f; q = q * t + (-0.142248368f); q = q * t + 0.127414796f; q = q * t;
    const f32x2 s = (v * v) * (-0.72134752044f);
    f32x2 e; e.x = __builtin_amdgcn_exp2f(s.x); e.y = __builtin_amdgcn_exp2f(s.y);
    const f32x2 m = v * (q * e), r = v - m;
    f32x2 o; o.x = v.x < 0.f ? m.x : r.x; o.y = v.y < 0.f ? m.y : r.y; return o;
}

template <int ACT  > struct EpiBf16 {
    static constexpr bool PERM = true, AFTER_DRAIN = false; static_assert(ACT == 0 || ACT == 1 || ACT == 2, "EpiBf16: ACT is 0 (none), 1 (gelu_pk) or 2 (squared relu)");
    bf16_t* O; int ldc; const float* bias; int split_cols; size_t split_stride; float scale0; const float* rowscale; PG8_LAS unsigned char* xlds; int tiled;
    __device__ __forceinline__ void operator()(const f32x4 (&acc)[2][2][4][2], const Unit& u, int wr, int wc, int fr, int fq) const {
        const int row0 = u.pm * BM + wr * 64 + fr; int colt = u.pn * BM; bf16_t* base = O;
        float sc = 1.f; if (split_cols) { const int t = colt / split_cols; base += (size_t)t * split_stride; colt -= t * split_cols; if (t == 0) sc = scale0; }
        const int col0 = colt + wc * 64 + 8 * fq, bcol0 = u.pn * BM + wc * 64 + 8 * fq;
        const int lane_ = fq * 16 + fr; PG8_LAS unsigned char* xw = xlds ? xlds + (wr * 4 + wc) * 2048 : xlds;
        float rs8[8];
#pragma unroll
        for (int i = 0; i < 8; ++i) rs8[i] = rowscale ? rowscale[row0 + (i >> 2) * HALF + (i & 3) * 16] : 1.f;
        f32x4 bv[2][2];
#pragma unroll
        for (int bj = 0; bj < 2; ++bj)
#pragma unroll
            for (int n = 0; n < 2; ++n) bv[bj][n] = bias ? *(const f32x4*)(bias + bcol0 + bj * 32 + 4 * n) : (f32x4){0.f, 0.f, 0.f, 0.f};
#pragma unroll
        for (int ai = 0; ai < 2; ++ai)
#pragma unroll
            for (int m = 0; m < 4; ++m) { bf16_t* rowp = base + (size_t)(row0 + ai * HALF + m * 16) * ldc + col0; const float rsv = rs8[ai * 4 + m];
#pragma unroll
                for (int bj = 0; bj < 2; ++bj) { f32x4 v0 = (acc[ai][bj][m][0] + bv[bj][0]) * rsv, v1 = (acc[ai][bj][m][1] + bv[bj][1]) * rsv;
                    if (ACT == 1) { f32x2 a = gelu_pk((f32x2){v0[0], v0[1]}), b = gelu_pk((f32x2){v0[2], v0[3]}), c = gelu_pk((f32x2){v1[0], v1[1]}), d = gelu_pk((f32x2){v1[2], v1[3]});
                        v0 = (f32x4){a.x, a.y, b.x, b.y}; v1 = (f32x4){c.x, c.y, d.x, d.y}; }
                    if (ACT == 2) { _Pragma("unroll") for (int e = 0; e < 4; ++e) { const float p0 = __builtin_fmaxf(v0[e], 0.f), p1 = __builtin_fmaxf(v1[e], 0.f); v0[e] = p0 * p0; v1[e] = p1 * p1; } }
                    v0 = v0 * sc; v1 = v1 * sc; u32x4 w; w.x = cvt_pk_bf16(v0[0], v0[1]); w.y = cvt_pk_bf16(v0[2], v0[3]); w.z = cvt_pk_bf16(v1[0], v1[1]); w.w = cvt_pk_bf16(v1[2], v1[3]);
                    if (tiled) *(u32x4*)(base + ((size_t)((u.pm * BM + wr * 64 + ai * HALF + m * 16) >> 4) * (ldc >> 5) + ((colt + wc * 64 + bj * 32) >> 5)) * 512 + fr * 32 + 8 * fq) = w;
                    else if (xlds) *(PG8_LAS u32x4*)(xw + fr * 128 + (((bj * 4 + fq) ^ (fr & 7)) << 4)) = w;
                    else *(u32x4*)(rowp + bj * 32) = w; }
                if (xlds && !tiled) { asm volatile("s_waitcnt lgkmcnt(0)" ::: "memory");
                    bf16_t* gp = base + (size_t)(u.pm * BM + wr * 64 + ai * HALF + m * 16) * ldc + colt + wc * 64;
#pragma unroll
                    for (int hh = 0; hh < 2; ++hh) { const int rr = (lane_ >> 3) + 8 * hh, ch = lane_ & 7;
                        const u32x4 t = *(const PG8_LAS u32x4*)(xw + rr * 128 + ((ch ^ (rr & 7)) << 4));
                        *(u32x4*)(gp + (size_t)rr * ldc + ch * 8) = t; }
                    asm volatile("s_waitcnt lgkmcnt(0)" ::: "memory"); } }
    }
};
template <class Epi, class Sched, bool ALIGN_EPI = false, bool SP2 = false, bool ATILED = false>
__device__ __forceinline__ void gemm_phase(PG8_LAS unsigned char* lds, const Gemm g, const Sched& S, const Epi& E) {
    int tid_ = threadIdx.x; asm volatile("" : "+v"(tid_));
    const int tid = tid_, wid = __builtin_amdgcn_readfirstlane(tid >> 6), lane = tid & 63, wr = wid >> 2, wc = wid & 3, fr = lane & 15, fq = lane >> 4;
    const int K = g.K, nt = K / BK;
    unsigned voffA[2], voffB[2];
#pragma unroll
    for (int i = 0; i < 2; ++i) { int R, C; stage_rc(tid * 16 + i * 8192, R, C); const int Rb = Epi::PERM ? (64 * (R >> 5) + perm32(R & 31)) : R;
        voffA[i] = ATILED ? (unsigned)(((R >> 4) * (K >> 5) + (C >> 5)) * 1024 + (R & 15) * 64 + (C & 31) * 2) : (unsigned)(R * K + C) * 2u; voffB[i] = (unsigned)(Rb * K + C) * 2u; }
    const size_t kstep = (size_t)(BK * 2);
    const size_t kstepA = ATILED ? (size_t)2048 : kstep;
    const size_t hstep = (size_t)HALF * K * 2;
    const size_t hstepB = Epi::PERM ? (size_t)32 * K * 2 : hstep;
    const size_t tstep = 2 * hstep;
    const unsigned ldsw = (unsigned)wid * 1024u;
    const int aoff = lds_byte(wr * 64 + fr, fq * 8), boff = lds_byte(wc * 32 + fr, fq * 8);
#define PG8_SA(b, h) (((b) * 2 + (h)) * HTB)
#define PG8_SB(b, h) ((4 + (b) * 2 + (h)) * HTB)
#define PG8_STAGE(bufoff, gbase, voff) do { _Pragma("unroll") for (int _i = 0; _i < 2; ++_i) \
        __builtin_amdgcn_global_load_lds((const unsigned*)((const char*)(gbase) + (voff)[_i]), (PG8_LAS unsigned*)(lds + (bufoff) + ldsw + _i * 8192), 16, 0, 0); } while (0)
#define PG8_LDA(dst, b, h) do { _Pragma("unroll") for (int m = 0; m < 4; ++m) _Pragma("unroll") for (int k = 0; k < 2; ++k) dst[m][k] = *(const PG8_LAS bf16x8*)(lds + PG8_SA(b, h) + aoff + m * 2048 + k * 1024); } while (0)
#define PG8_LDB(dst, b, h) do { _Pragma("unroll") for (int n = 0; n < 2; ++n) _Pragma("unroll") for (int k = 0; k < 2; ++k) dst[n][k] = *(const PG8_LAS bf16x8*)(lds + PG8_SB(b, h) + boff + n * 2048 + k * 1024); } while (0)
#define PG8_MMA(ai, bj, At, Bt) do { __builtin_amdgcn_s_setprio(1); _Pragma("unroll") for (int m = 0; m < 4; ++m) _Pragma("unroll") for (int n = 0; n < 2; ++n) _Pragma("unroll") for (int k = 0; k < 2; ++k) \
        acc[ai][bj][m][n] = __builtin_amdgcn_mfma_f32_16x16x32_bf16(Bt[n][k], At[m][k], acc[ai][bj][m][n], 0, 0, 0); __builtin_amdgcn_s_setprio(0); } while (0)
#define PG8_WAIT_V(n) asm volatile("s_waitcnt vmcnt(" #n ")" ::: "memory")
#define PG8_WAIT_L(n) asm volatile("s_waitcnt lgkmcnt(" #n ")" ::: "memory")
#define PG8_BAR __builtin_amdgcn_s_barrier()
#define PG8_SCHED __builtin_amdgcn_sched_barrier(0)
    Unit cur, nxt; int ui = 0;
    if (!S.next(0, cur)) return;
    f32x4 acc[2][2][4][2];
#pragma unroll
    for (int a = 0; a < 2; ++a)
#pragma unroll
        for (int b = 0; b < 2; ++b)
#pragma unroll
            for (int m = 0; m < 4; ++m)
#pragma unroll
                for (int n = 0; n < 2; ++n) acc[a][b][m][n] = (f32x4){0.f, 0.f, 0.f, 0.f};
    bf16x8 At[4][2], B0[2][2], B1[2][2];
    const char* cA = (const char*)g.A + (size_t)cur.pm * tstep; const char* cB = (const char*)g.Bt + (size_t)cur.pn * tstep;
    S.a_ready(cur);
    if constexpr (SP2) {
        PG8_STAGE(PG8_SB(0, 0), cB, voffB); PG8_STAGE(PG8_SB(0, 1), cB + hstepB, voffB); PG8_STAGE(PG8_SA(0, 0), cA, voffA); PG8_STAGE(PG8_SA(0, 1), cA + hstep, voffA);
        if (wr == 1) PG8_BAR;
        PG8_WAIT_V(2); PG8_BAR;
        PG8_STAGE(PG8_SB(1, 0), cB + kstep, voffB); PG8_STAGE(PG8_SA(1, 0), cA + kstepA, voffA); PG8_STAGE(PG8_SB(1, 1), cB + hstepB + kstep, voffB);
        PG8_WAIT_V(6); PG8_BAR;
    } else {
        PG8_STAGE(PG8_SB(0, 0), cB, voffB); PG8_STAGE(PG8_SA(0, 0), cA, voffA); PG8_STAGE(PG8_SB(0, 1), cB + hstepB, voffB); PG8_STAGE(PG8_SA(0, 1), cA + hstep, voffA);
        if (wr == 1) PG8_BAR;
        PG8_WAIT_V(4); PG8_BAR;
        PG8_STAGE(PG8_SB(1, 0), cB + kstep, voffB); PG8_STAGE(PG8_SA(1, 0), cA + kstepA, voffA); PG8_STAGE(PG8_SB(1, 1), cB + hstepB + kstep, voffB);
        PG8_WAIT_V(6); PG8_BAR;
    }
    for (;;) {
        const bool has_next = S.next(ui + 1, nxt);
        const char* nA = has_next ? (const char*)g.A + (size_t)nxt.pm * tstep : cA; const char* nB = has_next ? (const char*)g.Bt + (size_t)nxt.pn * tstep : cB;
        for (int t = 0; t < nt; t += 2) {
            const bool last = (t == nt - 2);
            const char* a1 = cA + (size_t)(t + 1) * kstepA;
            const char* a2 = last ? nA : cA + (size_t)(t + 2) * kstepA; const char* b2 = last ? nB : cB + (size_t)(t + 2) * kstep;
            const char* a3 = a2 + kstepA; const char* b3 = b2 + kstep;
            if (last && has_next) S.a_ready(nxt);
            if constexpr (SP2) {
            PG8_LDB(B0, 0, 0); PG8_LDB(B1, 0, 1); PG8_SCHED; PG8_LDA(At, 0, 0); PG8_STAGE(PG8_SA(1, 1), a1 + hstep, voffA);
            PG8_WAIT_V(8); PG8_WAIT_L(0); PG8_BAR; PG8_MMA(0, 0, At, B0); PG8_MMA(0, 1, At, B1); PG8_BAR; PG8_SCHED;
            PG8_LDA(At, 0, 1); PG8_STAGE(PG8_SB(0, 0), b2, voffB); PG8_STAGE(PG8_SB(0, 1), b2 + hstepB, voffB); PG8_STAGE(PG8_SA(0, 0), a2, voffA);
            PG8_WAIT_V(8); PG8_WAIT_L(0); PG8_BAR; PG8_MMA(1, 0, At, B0); PG8_MMA(1, 1, At, B1); PG8_BAR; PG8_SCHED;
            PG8_LDB(B0, 1, 0); PG8_LDB(B1, 1, 1); PG8_SCHED; PG8_LDA(At, 1, 0); PG8_STAGE(PG8_SA(0, 1), a2 + hstep, voffA);
            PG8_WAIT_V(8); PG8_WAIT_L(0); PG8_BAR; PG8_MMA(0, 0, At, B0); PG8_MMA(0, 1, At, B1); PG8_BAR; PG8_SCHED;
            PG8_LDA(At, 1, 1); PG8_STAGE(PG8_SB(1, 0), b3, voffB); PG8_STAGE(PG8_SB(1, 1), b3 + hstepB, voffB); PG8_STAGE(PG8_SA(1, 0), a3, voffA);
            PG8_WAIT_V(8); PG8_WAIT_L(0); PG8_BAR; PG8_MMA(1, 0, At, B0); PG8_MMA(1, 1, At, B1); PG8_BAR; PG8_SCHED;
            } else {
            PG8_LDB(B0, 0, 0); PG8_SCHED; PG8_LDA(At, 0, 0); PG8_STAGE(PG8_SA(1, 1), a1 + hstep, voffA);
            PG8_WAIT_L(8); PG8_BAR; PG8_WAIT_L(0); PG8_MMA(0, 0, At, B0); PG8_BAR; PG8_SCHED;
            PG8_LDB(B1, 0, 1); PG8_STAGE(PG8_SB(0, 0), b2, voffB);
            PG8_BAR; PG8_WAIT_L(0); PG8_MMA(0, 1, At, B1); PG8_BAR;
            PG8_LDA(At, 0, 1); PG8_STAGE(PG8_SA(0, 0), a2, voffA);
            PG8_BAR; PG8_WAIT_L(0); PG8_MMA(1, 0, At, B0); PG8_BAR; PG8_SCHED;
            PG8_STAGE(PG8_SB(0, 1), b2 + hstepB, voffB);
            PG8_WAIT_V(6); PG8_BAR; PG8_MMA(1, 1, At, B1); PG8_BAR;
            PG8_LDB(B0, 1, 0); PG8_SCHED; PG8_LDA(At, 1, 0); PG8_STAGE(PG8_SA(0, 1), a2 + hstep, voffA);
            PG8_WAIT_L(8); PG8_BAR; PG8_WAIT_L(0); PG8_MMA(0, 0, At, B0); PG8_BAR; PG8_SCHED;
            PG8_LDB(B1, 1, 1); PG8_STAGE(PG8_SB(1, 0), b3, voffB);
            PG8_BAR; PG8_WAIT_L(0); PG8_MMA(0, 1, At, B1); PG8_BAR;
            PG8_LDA(At, 1, 1); PG8_STAGE(PG8_SA(1, 0), a3, voffA);
            PG8_BAR; PG8_WAIT_L(0); PG8_MMA(1, 0, At, B0); PG8_BAR; PG8_SCHED;
            PG8_STAGE(PG8_SB(1, 1), b3 + hstepB, voffB);
            PG8_WAIT_V(6); PG8_BAR; PG8_MMA(1, 1, At, B1); PG8_BAR;
            }
        }
        if constexpr (ALIGN_EPI) { if (wr == 0) PG8_BAR; }
        if constexpr (!Epi::AFTER_DRAIN) { E(acc, cur, wr, wc, fr, fq); S.done(cur); }
        if (!has_next) break;
#pragma unroll
        for (int a = 0; a < 2; ++a)
#pragma unroll
            for (int b = 0; b < 2; ++b)
#pragma unroll
                for (int m = 0; m < 4; ++m)
#pragma unroll
                    for (int n = 0; n < 2; ++n) acc[a][b][m][n] = (f32x4){0.f, 0.f, 0.f, 0.f};
        cur = nxt; cA = nA; cB = nB; ++ui;
        if constexpr (ALIGN_EPI) { if (wr == 1) PG8_BAR; }
    }
    PG8_WAIT_V(0);
    if constexpr (!ALIGN_EPI) { if (wr == 0) PG8_BAR; }
    PG8_BAR;
    if constexpr (Epi::AFTER_DRAIN) { E.fused(acc, cur, wr, wc, fr, fq, lds, wid, lane); S.done(cur); }
#undef PG8_SA
#undef PG8_SB
#undef PG8_STAGE
#undef PG8_LDA
#undef PG8_LDB
#undef PG8_MMA
#undef PG8_WAIT_V
#undef PG8_WAIT_L
#undef PG8_BAR
#undef PG8_SCHED
}
}

#ifndef PG8_SP2
#define PG8_SP2 true
#endif
#ifndef PG8_ALIGN
#define PG8_ALIGN true
#endif

constexpr int NB = 8, SEQ = 4096, DM = 1024, DEPTH = 4, NH = 8, HD = 64, AW = 512, LW = 512, INW = 2560, DFF = 4096;
constexpr int M = NB * SEQ;
constexpr float EPS = 1e-6f;
constexpr float QSCALE = 0.125f * 1.4426950408889634f;

constexpr size_t MiB = 1u << 20;
constexpr size_t WS_CTL = 0;
constexpr size_t WS_WIN = 1 * MiB, WS_WOUT = 21 * MiB, WS_WFF1 = 29 * MiB, WS_WFF2 = 61 * MiB;
constexpr size_t WS_H = 96 * MiB;
constexpr size_t WS_XR = 160 * MiB;
constexpr size_t WS_MB = 224 * MiB;
constexpr size_t WS_OP01 = 96 * MiB;
constexpr size_t WS_OP2 = 448 * MiB;
constexpr size_t WS_LSE = 480 * MiB;
constexpr size_t WS_Z = 224 * MiB;
constexpr size_t WS_MIX = 384 * MiB;
constexpr size_t WS_A = 224 * MiB;
constexpr size_t WS_RS1 = 484 * MiB;
constexpr size_t WS_RS2 = 484 * MiB + 262144;
constexpr size_t WS_FX1 = 485 * MiB, WS_FX2 = 485 * MiB + 524288;
constexpr size_t WS_END = 486 * MiB;
__device__ __forceinline__ unsigned short* op_base(unsigned char* ws, int p) { return (unsigned short*)(ws + (p == 2 ? WS_OP2 : WS_OP01 + (size_t)p * (32 * MiB))); }

constexpr int LDS_BYTES = 151552;
constexpr int XEPI_LDS_OFF = 133120;
constexpr int NWAVES = 8;

#define LAS __attribute__((address_space(3)))
typedef unsigned short bf16;
typedef short bf16x8 __attribute__((ext_vector_type(8)));
typedef short s16x4 __attribute__((ext_vector_type(4)));
typedef float f32x4 __attribute__((ext_vector_type(4)));
typedef unsigned u32x4 __attribute__((ext_vector_type(4)));
typedef unsigned u32x2 __attribute__((ext_vector_type(2)));

__device__ __forceinline__ unsigned f2bf(float f) { unsigned u = __builtin_bit_cast(unsigned, f); return (u + 0x7fffu + ((u >> 16) & 1u)) >> 16; }
typedef float f32x2_t __attribute__((ext_vector_type(2))); typedef __bf16 bf16x2_t __attribute__((ext_vector_type(2)));
__device__ __forceinline__ unsigned pk2(float lo, float hi) { f32x2_t v = {lo, hi}; bf16x2_t b = __builtin_convertvector(v, bf16x2_t); return __builtin_bit_cast(unsigned, b); }
__device__ __forceinline__ float bflo(unsigned w) { return __uint_as_float(w << 16); }
__device__ __forceinline__ float bfhi(unsigned w) { return __uint_as_float(w & 0xffff0000u); }
__device__ __forceinline__ float wave_sum(float v) {
#pragma unroll
    for (int o = 1; o < 64; o <<= 1) v += __shfl_xor(v, o);
    return v;
}

__device__ __forceinline__ void p0_transpose_item(const float* W, int K, int N, bf16* WT, LAS float* scr, int item, int lane, const float* gk) {
    const int nblk = N / 32, kb = item / nblk, nb = item % nblk, k0 = 64 * kb, n0 = 32 * nb;
    const int kl = lane >> 3, c4 = lane & 7;
    f32x4 v[8];
#pragma unroll
    for (int i = 0; i < 8; ++i) v[i] = *(const f32x4*)(W + (size_t)(k0 + 8 * i + kl) * N + n0 + 4 * c4);
#pragma unroll
    for (int i = 0; i < 8; ++i) { const float gv = gk ? gk[k0 + 8 * i + kl] : 1.f; LAS float* d = scr + (8 * i + kl) * 33 + 4 * c4; d[0] = v[i].x * gv; d[1] = v[i].y * gv; d[2] = v[i].z * gv; d[3] = v[i].w * gv; }
    asm volatile("s_waitcnt lgkmcnt(0)" ::: "memory");
    const int c = lane & 7;
#pragma unroll
    for (int j = 0; j < 4; ++j) { const int n = (lane >> 3) + 8 * j; const LAS float* s = scr + (8 * c) * 33 + n;
        u32x4 o; o.x = pk2(s[0 * 33], s[1 * 33]); o.y = pk2(s[2 * 33], s[3 * 33]); o.z = pk2(s[4 * 33], s[5 * 33]); o.w = pk2(s[6 * 33], s[7 * 33]);
        *(u32x4*)(WT + (size_t)(n0 + n) * K + k0 + 8 * c) = o; }
    asm volatile("s_waitcnt lgkmcnt(0)" ::: "memory");
}

template <int R> __device__ __forceinline__ void rms_rows_to_bf16(const float* x, float* rsout, bf16* out, int m0, int mstride, int lane) {
    f32x4 v[R][4]; float s[R];
#pragma unroll
    for (int r = 0; r < R; ++r)
#pragma unroll
        for (int j = 0; j < 4; ++j) v[r][j] = *((const f32x4*)(x + (size_t)(m0 + r * mstride) * DM) + lane + 64 * j);
#pragma unroll
    for (int r = 0; r < R; ++r) { float a = 0.f;
#pragma unroll
        for (int j = 0; j < 4; ++j) a += (v[r][j].x * v[r][j].x + v[r][j].y * v[r][j].y) + (v[r][j].z * v[r][j].z + v[r][j].w * v[r][j].w);
        s[r] = a; }
#pragma unroll
    for (int o = 1; o < 64; o <<= 1)
#pragma unroll
        for (int r = 0; r < R; ++r) s[r] += __shfl_xor(s[r], o);
#pragma unroll
    for (int r = 0; r < R; ++r) { if (lane == 0) rsout[m0 + r * mstride] = __builtin_amdgcn_rsqf(s[r] * (1.f / DM) + EPS);
        u32x2* o8 = (u32x2*)(out + (size_t)(m0 + r * mstride) * DM) + lane;
#pragma unroll
        for (int j = 0; j < 4; ++j) { u32x2 w; w.x = pk2(v[r][j].x, v[r][j].y); w.y = pk2(v[r][j].z, v[r][j].w); o8[64 * j] = w; } }
}

template <int R, bool XIN32, bool XOUT32> __device__ __forceinline__ void post_norm_rows(const bf16* mb, const void* xin, void* xout, const float* gpost, float* rsout, int m0, int mstride, int lane) {
    f32x4 xv[R][4]; u32x2 mw[R][4]; float s[R];
#pragma unroll
    for (int r = 0; r < R; ++r)
#pragma unroll
        for (int j = 0; j < 4; ++j) { const size_t ro = (size_t)(m0 + r * mstride) * DM; mw[r][j] = *((const u32x2*)(mb + ro) + lane + 64 * j);
            if (XIN32) xv[r][j] = *((const f32x4*)((const float*)xin + ro) + lane + 64 * j);
            else { const u32x2 w = *((const u32x2*)((const bf16*)xin + ro) + lane + 64 * j); xv[r][j] = (f32x4){bflo(w.x), bfhi(w.x), bflo(w.y), bfhi(w.y)}; } }
    f32x4 gg[4];
#pragma unroll
    for (int j = 0; j < 4; ++j) gg[j] = *((const f32x4*)gpost + lane + 64 * j);
#pragma unroll
    for (int r = 0; r < R; ++r) { float a = 0.f;
#pragma unroll
        for (int j = 0; j < 4; ++j) { const float a0 = bflo(mw[r][j].x), a1 = bfhi(mw[r][j].x), a2 = bflo(mw[r][j].y), a3 = bfhi(mw[r][j].y); a += (a0 * a0 + a1 * a1) + (a2 * a2 + a3 * a3); }
        s[r] = a; }
#pragma unroll
    for (int o = 1; o < 64; o <<= 1)
#pragma unroll
        for (int r = 0; r < R; ++r) s[r] += __shfl_xor(s[r], o);
#pragma unroll
    for (int r = 0; r < R; ++r) { const float rs = __builtin_amdgcn_rsqf(s[r] * (1.f / DM) + EPS); float a = 0.f; const size_t ro = (size_t)(m0 + r * mstride) * DM;
#pragma unroll
        for (int j = 0; j < 4; ++j) { const f32x4 mv = {bflo(mw[r][j].x), bfhi(mw[r][j].x), bflo(mw[r][j].y), bfhi(mw[r][j].y)};
            xv[r][j] = xv[r][j] + mv * rs * gg[j];
            if (XOUT32) *((f32x4*)((float*)xout + ro) + lane + 64 * j) = xv[r][j];
            else { u32x2 w; w.x = pk2(xv[r][j].x, xv[r][j].y); w.y = pk2(xv[r][j].z, xv[r][j].w); *((u32x2*)((bf16*)xout + ro) + lane + 64 * j) = w; }
            a += (xv[r][j].x * xv[r][j].x + xv[r][j].y * xv[r][j].y) + (xv[r][j].z * xv[r][j].z + xv[r][j].w * xv[r][j].w); }
        s[r] = a; }
    if (rsout) {
#pragma unroll
        for (int o = 1; o < 64; o <<= 1)
#pragma unroll
            for (int r = 0; r < R; ++r) s[r] += __shfl_xor(s[r], o);
#pragma unroll
        for (int r = 0; r < R; ++r) if (lane == 0) rsout[m0 + r * mstride] = __builtin_amdgcn_rsqf(s[r] * (1.f / DM) + EPS);
    }
}

constexpr int LRU_LDS_OFF = 98304;
constexpr int XB_LDS_OFF = 132096;
__device__ __forceinline__ float sigmoidf_(float x) { return __builtin_amdgcn_rcpf(1.0f + __builtin_amdgcn_exp2f(-1.4426950408889634f * x)); }
__device__ __forceinline__ float gelu_tanh(float g) { const float y2 = (2.0f * 0.7978845608028654f) * (g + 0.044715f * g * g * g); return g * sigmoidf_(y2); }

__device__ __forceinline__ void lru_unit(int unit, const bf16* Z, bf16* MIX, const float* conv_w, const float* conv_b, const float* w_r, const float* b_r,
                                         const float* w_i, const float* b_i, const float* lam, LAS unsigned char* lds) {
    const int qt = unit & 3, n = (unit >> 2) & 7, b = unit >> 5;
    int tid_ = threadIdx.x; asm volatile("" : "+v"(tid_));
    const int tid = tid_, lane = tid & 63, wid = __builtin_amdgcn_readfirstlane(tid >> 6), l15 = lane & 15, fq = lane >> 4;
    bf16x8 wd[4][2]; f32x4 cbv[4];
    bf16x8 wr[2], wi[2], wx[2];
#pragma unroll
    for (int ct = 0; ct < 4; ++ct) {
#pragma unroll
        for (int r = 0; r < 4; ++r) cbv[ct][r] = conv_b[64 * n + 16 * ct + 4 * fq + r];
#pragma unroll
        for (int ksp = 0; ksp < 2; ++ksp)
#pragma unroll
            for (int j = 0; j < 8; ++j) { const int tap = 2 * ksp + (fq >> 1), chl = 8 * (fq & 1) + j;
                wd[ct][ksp][j] = (chl == l15) ? (short)f2bf(conv_w[tap * LW + 64 * n + 16 * ct + chl]) : (short)0; }
    }
#pragma unroll
    for (int ks = 0; ks < 2; ++ks)
#pragma unroll
        for (int j = 0; j < 8; ++j) { const int sig = 16 * (2 * ks + (j >> 2)) + 4 * fq + (j & 3);
            wr[ks][j] = (short)f2bf(w_r[(size_t)(n * 64 + sig) * 64 + 16 * qt + l15]);
            wi[ks][j] = (short)f2bf(w_i[(size_t)(n * 64 + sig) * 64 + 16 * qt + l15]);
            wx[ks][j] = (sig == 16 * qt + l15) ? (short)0x3F80 : (short)0; }
    const int chan = 64 * n + 16 * qt + l15;
    const float br = b_r[chan], bi = b_i[chan], sp8 = -8.0f * log1pf(__expf(-lam[chan]));
    const bf16* Zb = Z + (size_t)b * SEQ * INW;
    bf16* Ob = MIX + (size_t)b * SEQ * DM + AW + chan;
    float hseg = 0.f;
    const bf16* Zx = Zb + 1536 + 64 * n + 8 * (fq & 1);
#define LRU_LOAD(dst, tbase) do { _Pragma("unroll") for (int ksp_ = 0; ksp_ < 2; ++ksp_) { int tt_ = (tbase) + l15 - 3 + 2 * ksp_ + (fq >> 1); tt_ = tt_ < 0 ? 0 : (tt_ > SEQ - 1 ? SEQ - 1 : tt_); \
        _Pragma("unroll") for (int ct_ = 0; ct_ < 4; ++ct_) dst[ct_][ksp_] = *(const u32x4*)(Zx + (size_t)tt_ * INW + 16 * ct_); } } while (0)
    u32x4 bufA[4][2], bufB[4][2];
    unsigned short grn[4][4];
    LRU_LOAD(bufA, wid * 64); LRU_LOAD(bufB, wid * 64 + 16);
#pragma unroll
    for (int mt = 0; mt < 4; ++mt)
#pragma unroll
        for (int r = 0; r < 4; ++r) grn[mt][r] = Zb[(size_t)(wid * 64 + 16 * mt + 4 * fq + r) * INW + 2048 + chan];
    for (int seg = 0; seg < 8; ++seg) {
        const int tw = seg * 512 + wid * 64;
        float Cel[4][4], Hel[4][4];
        unsigned short grv[4][4];
#pragma unroll
        for (int mt = 0; mt < 4; ++mt)
#pragma unroll
            for (int r = 0; r < 4; ++r) { grv[mt][r] = grn[mt][r]; const int tn = tw + 512 + 16 * mt + 4 * fq + r; grn[mt][r] = Zb[(size_t)(tn > SEQ - 1 ? SEQ - 1 : tn) * INW + 2048 + chan]; }
        float Cw = 1.f, Hw = 0.f;
#pragma unroll
        for (int mt = 0; mt < 4; ++mt) {
            const int t = tw + 16 * mt + l15;
            f32x4 accr = {0.f, 0.f, 0.f, 0.f}, acci = {0.f, 0.f, 0.f, 0.f}, accx = {0.f, 0.f, 0.f, 0.f};
            f32x4 cacc[4];
#pragma unroll
            for (int ct = 0; ct < 4; ++ct) {
                cacc[ct] = cbv[ct];
#pragma unroll
                for (int ksp = 0; ksp < 2; ++ksp) {
                    u32x4 v = (mt & 1) ? bufB[ct][ksp] : bufA[ct][ksp];
                    if ((tw + 16 * mt) == 0) { if (t - 3 + 2 * ksp + (fq >> 1) < 0) v = (u32x4){0u, 0u, 0u, 0u}; }
                    cacc[ct] = __builtin_amdgcn_mfma_f32_16x16x32_bf16(wd[ct][ksp], __builtin_bit_cast(bf16x8, v), cacc[ct], 0, 0, 0);
                }
            }
            { const int tb = (mt < 2) ? tw + 16 * (mt + 2) : tw + 512 + 16 * (mt - 2); if (mt & 1) LRU_LOAD(bufB, tb); else LRU_LOAD(bufA, tb); }
#pragma unroll
            for (int ks = 0; ks < 2; ++ks) {
                u32x4 ap; ap.x = pk2(cacc[2 * ks][0], cacc[2 * ks][1]); ap.y = pk2(cacc[2 * ks][2], cacc[2 * ks][3]);
                ap.z = pk2(cacc[2 * ks + 1][0], cacc[2 * ks + 1][1]); ap.w = pk2(cacc[2 * ks + 1][2], cacc[2 * ks + 1][3]);
                const bf16x8 a = __builtin_bit_cast(bf16x8, ap);
                accr = __builtin_amdgcn_mfma_f32_16x16x32_bf16(a, wr[ks], accr, 0, 0, 0);
                acci = __builtin_amdgcn_mfma_f32_16x16x32_bf16(a, wi[ks], acci, 0, 0, 0);
                accx = __builtin_amdgcn_mfma_f32_16x16x32_bf16(a, wx[ks], accx, 0, 0, 0);
            }
            float C[4], H[4];
#pragma unroll
            for (int r = 0; r < 4; ++r) {
                const float rg = sigmoidf_(accr[r] + br), ig = sigmoidf_(acci[r] + bi);
                const float la = sp8 * rg; const float a_ = __builtin_amdgcn_exp2f(1.4426950408889634f * la); const float mult = __builtin_amdgcn_sqrtf(fmaxf(1.0f - a_ * a_, 0.f));
                const float u_ = mult * ig * accx[r];
                if (r == 0) { C[0] = a_; H[0] = u_; } else { C[r] = a_ * C[r - 1]; H[r] = a_ * H[r - 1] + u_; }
            }
            float Ct = C[3], Ht = H[3];
            { const float Cp = __shfl_up(Ct, 16), Hp = __shfl_up(Ht, 16); if (fq >= 1) { Ht = Ct * Hp + Ht; Ct = Ct * Cp; } }
            { const float Cp = __shfl_up(Ct, 32), Hp = __shfl_up(Ht, 32); if (fq >= 2) { Ht = Ct * Hp + Ht; Ct = Ct * Cp; } }
            float Ce = __shfl_up(Ct, 16), He = __shfl_up(Ht, 16); if (fq == 0) { Ce = 1.f; He = 0.f; }
            const float Ctile = __shfl(Ct, 48 + l15), Htile = __shfl(Ht, 48 + l15);
            const float Cp = Cw * Ce, Hp = Ce * Hw + He;
#pragma unroll
            for (int r = 0; r < 4; ++r) { Cel[mt][r] = Cp * C[r]; Hel[mt][r] = C[r] * Hp + H[r]; }
            Hw = Ctile * Hw + Htile; Cw = Cw * Ctile;
        }
        LAS float* tot = (LAS float*)(lds + LRU_LDS_OFF) + (seg & 1) * 256;
        if (fq == 0) { tot[(wid * 16 + l15) * 2] = Cw; tot[(wid * 16 + l15) * 2 + 1] = Hw; }
        __syncthreads();
        float hin = hseg, hall = hseg;
#pragma unroll
        for (int w2 = 0; w2 < 8; ++w2) { const float c2 = tot[(w2 * 16 + l15) * 2], h2 = tot[(w2 * 16 + l15) * 2 + 1]; hall = c2 * hall + h2; if (w2 < wid) hin = hall; }
#pragma unroll
        for (int mt = 0; mt < 4; ++mt)
#pragma unroll
            for (int r = 0; r < 4; ++r) {
                const float hv = Cel[mt][r] * hin + Hel[mt][r];
                const float g = __uint_as_float((unsigned)grv[mt][r] << 16);
                Ob[(size_t)(tw + 16 * mt + 4 * fq + r) * DM] = (bf16)f2bf(hv * gelu_tanh(g));
            }
        hseg = hall;
    }
#undef LRU_LOAD
    __syncthreads();
}

constexpr int AT_PITCH = 160;
constexpr int AT_K = 0, AT_V = 384 * AT_PITCH;
constexpr int ATT_UNITS = NB * NH * 3 * 16;

struct AttPre { u32x4 k[6], v[6], q[4]; };
__device__ __forceinline__ void att_decode(int u, int& b, int& h, int& br, int& dsh, int& c, int& n2) {
    const int blk = u & 15, t = u >> 4; br = t % 3; const int bh = t / 3; h = bh & 7; b = bh >> 3; dsh = 2 * br; c = blk >> (4 - dsh); n2 = blk & ((16 >> dsh) - 1);
}
__device__ __forceinline__ void att_issue(int u, const bf16* Z, AttPre& P) {
    int b, h, br, dsh, c, n2; att_decode(u, b, h, br, dsh, c, n2);
    int tid_ = threadIdx.x; asm volatile("" : "+v"(tid_));
    const int tid = tid_, lane = tid & 63, wid = tid >> 6, l15 = lane & 15, fq = lane >> 4;
    const bf16* Zb = Z + (size_t)b * SEQ * INW + h * HD;
#pragma unroll
    for (int i = 0; i < 6; ++i) {
        const int id = tid + 512 * i, row = id >> 3, ch = id & 7; int tau = n2 * 256 - 128 + row; tau = tau < 0 ? 0 : tau;
        const bf16* p = Zb + (size_t)((tau << dsh) + c) * INW + ch * 8;
        P.k[i] = *(const u32x4*)(p + AW); P.v[i] = *(const u32x4*)(p + 2 * AW);
    }
#pragma unroll
    for (int blk = 0; blk < 2; ++blk) {
        const int posq = ((n2 * 256 + 128 * blk + 16 * wid + l15) << dsh) + c;
#pragma unroll
        for (int ks = 0; ks < 2; ++ks) P.q[2 * blk + ks] = *(const u32x4*)(Zb + (size_t)posq * INW + 32 * ks + 8 * fq);
    }
}
__device__ __forceinline__ void att_stage(const AttPre& P, LAS unsigned char* lds) {
    int tid_ = threadIdx.x; asm volatile("" : "+v"(tid_)); const int tid = tid_;
#pragma unroll
    for (int i = 0; i < 6; ++i) { const int id = tid + 512 * i, row = id >> 3, ch = id & 7;
        *(LAS u32x4*)(lds + AT_K + row * AT_PITCH + ch * 16) = P.k[i]; *(LAS u32x4*)(lds + AT_V + row * AT_PITCH + ch * 16) = P.v[i]; }
}
__device__ __forceinline__ s16x4 vtr(const LAS unsigned char* p) { return __builtin_bit_cast(s16x4, __builtin_amdgcn_ds_read_tr16_b64_v4i16((LAS s16x4*)p)); }

__device__ __forceinline__ void att_compute(int u, int blk, const u32x4& qf0, const u32x4& qf1, unsigned char* ws, float* LSE, LAS unsigned char* lds) {
    int b, h, br, dsh, c, n2; att_decode(u, b, h, br, dsh, c, n2); const int n = 2 * n2 + blk;
    int tid_ = threadIdx.x; asm volatile("" : "+v"(tid_));
    const int tid = tid_, lane = tid & 63, wid = __builtin_amdgcn_readfirstlane(tid >> 6), l15 = lane & 15, fq = lane >> 4;
    const bf16x8 q0 = __builtin_bit_cast(bf16x8, qf0), q1 = __builtin_bit_cast(bf16x8, qf1);
    f32x4 s[9];
    const LAS unsigned char* kb = lds + AT_K + (128 * blk + 16 * wid + l15) * AT_PITCH + fq * 16;
#pragma unroll
    for (int j = 0; j < 9; ++j) {
        const bf16x8 a0 = *(const LAS bf16x8*)(kb + j * 16 * AT_PITCH), a1 = *(const LAS bf16x8*)(kb + j * 16 * AT_PITCH + 64);
        f32x4 acc = {0.f, 0.f, 0.f, 0.f};
        acc = __builtin_amdgcn_mfma_f32_16x16x32_bf16(a0, q0, acc, 0, 0, 0);
        acc = __builtin_amdgcn_mfma_f32_16x16x32_bf16(a1, q1, acc, 0, 0, 0);
        s[j] = acc;
    }
    const float NEG = -INFINITY;
#pragma unroll
    for (int r = 0; r < 4; ++r) { const int dlt = 4 * fq + r - l15; if (dlt < 0) s[0][r] = NEG; if (dlt > 0) s[8][r] = NEG; }
    if (n == 0) {
#pragma unroll
        for (int j = 0; j < 8; ++j) if (wid + j < 8) s[j] = (f32x4){NEG, NEG, NEG, NEG};
    }
    float m = NEG;
#pragma unroll
    for (int j = 0; j < 9; ++j) m = fmaxf(m, fmaxf(fmaxf(s[j][0], s[j][1]), fmaxf(s[j][2], s[j][3])));
    m = fmaxf(m, __shfl_xor(m, 16)); m = fmaxf(m, __shfl_xor(m, 32));
    float l = 0.f;
#pragma unroll
    for (int j = 0; j < 9; ++j)
#pragma unroll
        for (int r = 0; r < 4; ++r) { const float p = __builtin_amdgcn_exp2f(s[j][r] - m); s[j][r] = p; l += p; }
    l += __shfl_xor(l, 16); l += __shfl_xor(l, 32);
    bf16x8 pb[5];
#pragma unroll
    for (int pr = 0; pr < 5; ++pr) {
        u32x4 w; w.x = pk2(s[2 * pr][0], s[2 * pr][1]); w.y = pk2(s[2 * pr][2], s[2 * pr][3]);
        if (pr < 4) { w.z = pk2(s[2 * pr + 1][0], s[2 * pr + 1][1]); w.w = pk2(s[2 * pr + 1][2], s[2 * pr + 1][3]); } else { w.z = 0u; w.w = 0u; }
        pb[pr] = __builtin_bit_cast(bf16x8, w);
    }
    const LAS unsigned char* vb = lds + AT_V + (128 * blk + 16 * wid + 4 * fq + (l15 >> 2)) * AT_PITCH + (l15 & 3) * 8;
    f32x4 o[4];
#pragma unroll
    for (int dt = 0; dt < 4; ++dt) {
        f32x4 acc = {0.f, 0.f, 0.f, 0.f};
#pragma unroll
        for (int pr = 0; pr < 5; ++pr) {
            const s16x4 lo = vtr(vb + (2 * pr) * 16 * AT_PITCH + dt * 32);
            s16x4 hi = {0, 0, 0, 0};
            if (pr < 4) hi = vtr(vb + (2 * pr + 1) * 16 * AT_PITCH + dt * 32);
            const bf16x8 a = {lo[0], lo[1], lo[2], lo[3], hi[0], hi[1], hi[2], hi[3]};
            acc = __builtin_amdgcn_mfma_f32_16x16x32_bf16(a, pb[pr], acc, 0, 0, 0);
        }
        o[dt] = acc;
    }
    const float inv = __builtin_amdgcn_rcpf(l);
    const int posq = ((n * 128 + 16 * wid + l15) << dsh) + c;
    const size_t row = (size_t)b * SEQ + posq;
    bf16* op = op_base(ws, br) + row * AW + h * HD + 4 * fq;
#pragma unroll
    for (int dt = 0; dt < 4; ++dt) { u32x2 w; w.x = pk2(o[dt][0] * inv, o[dt][1] * inv); w.y = pk2(o[dt][2] * inv, o[dt][3] * inv); *(u32x2*)(op + 16 * dt) = w; }
    if (fq == 0) LSE[((size_t)br * M + row) * NH + h] = m + __builtin_amdgcn_logf(l);
}

__device__ __forceinline__ void att_combine(unsigned char* ws, const float* LSE, bf16* MIX, int gtid, int gthreads) {
    for (int id = gtid; id < M * 64; id += gthreads) {
        const int row = id >> 6, ch = id & 63, h = ch >> 3;
        float L[3];
#pragma unroll
        for (int p = 0; p < 3; ++p) L[p] = LSE[((size_t)p * M + row) * NH + h];
        const float mx = fmaxf(L[0], fmaxf(L[1], L[2]));
        float w[3]; float sw = 0.f;
#pragma unroll
        for (int p = 0; p < 3; ++p) { w[p] = __builtin_amdgcn_exp2f(L[p] - mx); sw += w[p]; }
        const float isw = __builtin_amdgcn_rcpf(sw);
        float acc[8] = {0.f, 0.f, 0.f, 0.f, 0.f, 0.f, 0.f, 0.f};
#pragma unroll
        for (int p = 0; p < 3; ++p) { const u32x4 v = *(const u32x4*)(op_base(ws, p) + (size_t)row * AW + ch * 8); const float ww = w[p] * isw;
            acc[0] += ww * bflo(v.x); acc[1] += ww * bfhi(v.x); acc[2] += ww * bflo(v.y); acc[3] += ww * bfhi(v.y);
            acc[4] += ww * bflo(v.z); acc[5] += ww * bfhi(v.z); acc[6] += ww * bflo(v.w); acc[7] += ww * bfhi(v.w); }
        u32x4 o; o.x = pk2(acc[0], acc[1]); o.y = pk2(acc[2], acc[3]); o.z = pk2(acc[4], acc[5]); o.w = pk2(acc[6], acc[7]);
        *(u32x4*)(MIX + (size_t)row * DM + ch * 8) = o;
    }
}

#define XB_TMO      128
#define XB_XCNT(j)  (256  + 64 * (j))
#define XB_XSUB(j)  (1280 + 64 * (j))
#define XB_XGEN(j)  (2304 + 64 * (j))
#define XB_TOP      3328
#define XB_TOPGEN   3392
#define XCD_BAR_WORDS 3456
#define XB_SPIN_CAP (1u << 18)

__device__ __forceinline__ unsigned xb_ld(unsigned* p)              { return __hip_atomic_load(p, __ATOMIC_RELAXED, __HIP_MEMORY_SCOPE_AGENT); }
__device__ __forceinline__ unsigned xb_add(unsigned* p, unsigned v) { return __hip_atomic_fetch_add(p, v, __ATOMIC_RELAXED, __HIP_MEMORY_SCOPE_AGENT); }
__device__ __forceinline__ unsigned xb_xcc_id() { return (unsigned)__builtin_amdgcn_s_getreg((3 << 11) | 20) & 0xFu; }
#define XB_SPIN(cond, bar) do { unsigned _sp = 0; while (cond) { __builtin_amdgcn_s_sleep(1); \
    if ((++_sp & 255u) == 0u) { if (xb_ld(&(bar)[XB_TMO])) break; if (_sp > XB_SPIN_CAP) { atomicAdd(&(bar)[XB_TMO], 1u); break; } } } } while (0)

struct XcdBarrier {
    unsigned* bar; unsigned x;
    volatile LAS unsigned* st;
};

__device__ __forceinline__ XcdBarrier xcd_barrier_post(unsigned* bar, volatile LAS unsigned* st) {
    XcdBarrier b; b.bar = bar; b.x = xb_xcc_id(); b.st = st;
    if (threadIdx.x == 0) (void)xb_add(&bar[XB_XCNT(b.x)], 1u);
    return b;
}
__device__ __forceinline__ void xcd_barrier_complete(unsigned* bar, unsigned x, unsigned& nloc, unsigned& nx) {
    const unsigned G = gridDim.x * gridDim.y * gridDim.z;
    unsigned sum, cnt, mine, sp = 0u;
    for (;;) {
        sum = 0u; cnt = 0u; mine = 0u;
#pragma unroll
        for (unsigned j = 0; j < 16; ++j) { const unsigned c = xb_ld(&bar[XB_XCNT(j)]); sum += c; cnt += (c > 0u) ? 1u : 0u; mine = (j == x) ? c : mine; }
        if (sum == G) break;
        __builtin_amdgcn_s_sleep(1);
        if ((++sp & 255u) == 0u) { if (xb_ld(&bar[XB_TMO])) break; if (sp > XB_SPIN_CAP) { atomicAdd(&bar[XB_TMO], 1u); break; } }
    }
    nloc = mine > 0u ? mine : 1u; nx = cnt > 0u ? cnt : 1u;
}

__device__ __forceinline__ void xcd_barrier(const XcdBarrier& b) {
    asm volatile("s_waitcnt vmcnt(0)" ::: "memory");
    __syncthreads();
    if (threadIdx.x == 0) {
        unsigned* bar = b.bar;
        __builtin_amdgcn_s_waitcnt(0);
        unsigned nloc = b.st[0], nx = b.st[1];
        if (nloc == 0u) { xcd_barrier_complete(bar, b.x, nloc, nx); b.st[0] = nloc; b.st[1] = nx; }
        const unsigned old = xb_add(&bar[XB_XSUB(b.x)], 1u);
        const unsigned gen = old / nloc;
        if (old + 1u == (gen + 1u) * nloc) {
            __builtin_amdgcn_fence(__ATOMIC_RELEASE, "agent");
            asm volatile("s_waitcnt vmcnt(0)" ::: "memory");
            const unsigned og = xb_add(&bar[XB_TOP], 1u);
            const unsigned tg = og / nx;
            if (og + 1u == (tg + 1u) * nx) xb_add(&bar[XB_TOPGEN], 1u);
            else XB_SPIN(xb_ld(&bar[XB_TOPGEN]) == tg, bar);
            __builtin_amdgcn_fence(__ATOMIC_ACQUIRE, "agent");
            xb_add(&bar[XB_XGEN(b.x)], 1u);
            asm volatile("s_waitcnt vmcnt(0)" ::: "memory");
        } else {
            XB_SPIN(xb_ld(&bar[XB_XGEN(b.x)]) == gen, bar);
            __builtin_amdgcn_fence(__ATOMIC_ACQUIRE, "agent");
            asm volatile("s_waitcnt vmcnt(0)" ::: "memory");
        }
    }
    __syncthreads();
}


constexpr int FX_CNT_WORD = 16384;
struct RowStats {
    float* slots;
    unsigned* cnt;
    __device__ __forceinline__ void run(const pg8::f32x4 (&v)[2][2][4][2], const pg8::Unit& u, int wr, int wc, int fr, int fq, LAS unsigned char* lds, int wid, int lane, const float* rprev) const {
        LAS float* P = (LAS float*)lds;
        LAS float* S = (LAS float*)(lds + 8192);
#pragma unroll
        for (int ai = 0; ai < 2; ++ai)
#pragma unroll
            for (int mm = 0; mm < 4; ++mm) {
                float s = 0.f;
#pragma unroll
                for (int bj = 0; bj < 2; ++bj)
#pragma unroll
                    for (int n = 0; n < 2; ++n) { const pg8::f32x4 x = v[ai][bj][mm][n]; s += (x[0] * x[0] + x[1] * x[1]) + (x[2] * x[2] + x[3] * x[3]); }
                s += __shfl_xor(s, 16); s += __shfl_xor(s, 32);
                if (fq == 0) P[(ai * 128 + wr * 64 + mm * 16 + fr) * 4 + wc] = s;
            }
        asm volatile("s_waitcnt lgkmcnt(0)" ::: "memory"); __builtin_amdgcn_s_barrier(); asm volatile("" ::: "memory");
        const int row = wid * 32 + (lane & 31);
        const float pr = rprev[u.pm * 256 + row];
        if (lane < 32) {
            const float t = (P[row * 4 + 0] + P[row * 4 + 1]) + (P[row * 4 + 2] + P[row * 4 + 3]);
            __hip_atomic_store(slots + ((size_t)(u.pm * 256 + row) * 4 + u.pn), t, __ATOMIC_RELAXED, __HIP_MEMORY_SCOPE_AGENT);
        }
        asm volatile("s_waitcnt vmcnt(0)" ::: "memory");
        if (lane == 0) __hip_atomic_fetch_add(cnt + 64 * u.pm, 1u, __ATOMIC_RELAXED, __HIP_MEMORY_SCOPE_AGENT);
        if (wid == 0) { unsigned sp = 0;
            while ((unsigned)__builtin_amdgcn_readfirstlane(__hip_atomic_load(cnt + 64 * u.pm, __ATOMIC_RELAXED, __HIP_MEMORY_SCOPE_AGENT)) < 32u && ++sp < (1u << 22)) __builtin_amdgcn_s_sleep(1); }
        asm volatile("s_waitcnt vmcnt(0) lgkmcnt(0)" ::: "memory"); __builtin_amdgcn_s_barrier(); asm volatile("" ::: "memory");
        if (lane < 32) {
            const float* sl = slots + (size_t)(u.pm * 256 + row) * 4; float t = 0.f;
#pragma unroll
            for (int k = 0; k < 4; ++k) t += __hip_atomic_load(sl + k, __ATOMIC_RELAXED, __HIP_MEMORY_SCOPE_AGENT);
            const float p2 = pr * pr; S[row] = t * (1.f / DM) + EPS * __builtin_amdgcn_rcpf(p2 * p2);
        }
        asm volatile("s_waitcnt vmcnt(0) lgkmcnt(0)" ::: "memory"); __builtin_amdgcn_s_barrier(); asm volatile("" ::: "memory");
    }
};
struct EpiRmsRes {
    static constexpr bool PERM = true, AFTER_DRAIN = true;
    const void* xin; void* xout; const float* gpost; float* rsout; RowStats st1, st2; int xin32, last; const float* rsprev; const float* ones;
    __device__ __forceinline__ void fused(pg8::f32x4 (&acc)[2][2][4][2], const pg8::Unit& u, int wr, int wc, int fr, int fq, LAS unsigned char* lds, int wid, int lane) const {
        const LAS float* S = (const LAS float*)(lds + 8192);
        const int col0 = u.pn * 256 + wc * 64 + 8 * fq;
        u32x4 xpre[2][4][2];
        if (!xin32) {
#pragma unroll
            for (int ai = 0; ai < 2; ++ai)
#pragma unroll
                for (int mm = 0; mm < 4; ++mm) { const size_t off = (size_t)(u.pm * 256 + ai * 128 + wr * 64 + mm * 16 + fr) * DM + col0;
#pragma unroll
                    for (int bj = 0; bj < 2; ++bj) xpre[ai][mm][bj] = *(const u32x4*)((const bf16*)xin + off + bj * 32); }
        }
        st1.run(acc, u, wr, wc, fr, fq, lds, wid, lane, rsprev);
        pg8::f32x4 gv[2][2];
#pragma unroll
        for (int bj = 0; bj < 2; ++bj)
#pragma unroll
            for (int n = 0; n < 2; ++n) gv[bj][n] = *(const pg8::f32x4*)(gpost + col0 + bj * 32 + n * 4);
#pragma unroll
        for (int ai = 0; ai < 2; ++ai)
#pragma unroll
            for (int mm = 0; mm < 4; ++mm) {
                const int r = ai * 128 + wr * 64 + mm * 16 + fr; const float rs = __builtin_amdgcn_rsqf(S[r]);
                const size_t off = (size_t)(u.pm * 256 + r) * DM + col0;
#pragma unroll
                for (int bj = 0; bj < 2; ++bj) {
                    pg8::f32x4 xa, xb;
                    if (xin32) { xa = *(const pg8::f32x4*)((const float*)xin + off + bj * 32); xb = *(const pg8::f32x4*)((const float*)xin + off + bj * 32 + 4); }
                    else { const u32x4 w = xpre[ai][mm][bj]; xa = (pg8::f32x4){bflo(w.x), bfhi(w.x), bflo(w.y), bfhi(w.y)}; xb = (pg8::f32x4){bflo(w.z), bfhi(w.z), bflo(w.w), bfhi(w.w)}; }
                    const pg8::f32x4 ya = xa + acc[ai][bj][mm][0] * rs * gv[bj][0], yb = xb + acc[ai][bj][mm][1] * rs * gv[bj][1];
                    acc[ai][bj][mm][0] = ya; acc[ai][bj][mm][1] = yb;
                    if (last) { *(pg8::f32x4*)((float*)xout + off + bj * 32) = ya; *(pg8::f32x4*)((float*)xout + off + bj * 32 + 4) = yb; }
                    else { u32x4 w; w.x = pk2(ya[0], ya[1]); w.y = pk2(ya[2], ya[3]); w.z = pk2(yb[0], yb[1]); w.w = pk2(yb[2], yb[3]); *(u32x4*)((bf16*)xout + off + bj * 32) = w; }
                }
                if (mm & 1) asm volatile("" ::: "memory");
            }
        if (!last) {
            st2.run(acc, u, wr, wc, fr, fq, lds, wid, lane, ones);
            if (u.pn == 0 && wc == 0 && fq == 0) {
#pragma unroll
                for (int ai = 0; ai < 2; ++ai)
#pragma unroll
                    for (int mm = 0; mm < 4; ++mm) { const int r = ai * 128 + wr * 64 + mm * 16 + fr; rsout[u.pm * 256 + r] = __builtin_amdgcn_rsqf(S[r]); }
            }
        }
        asm volatile("s_waitcnt lgkmcnt(0)" ::: "memory"); __builtin_amdgcn_s_barrier(); asm volatile("" ::: "memory");
    }
};
struct OneUnit {
    pg8::StaticOrder base; int round;
    __device__ __forceinline__ bool next(int i, pg8::Unit& u) const { return i == 0 && base.next(round, u); }
    __device__ __forceinline__ void a_ready(const pg8::Unit&) const {}
    __device__ __forceinline__ void done(const pg8::Unit&) const {}
};

#ifndef REP_SYNC
#define REP_SYNC 1
#endif
#define GSYNC() do { for (int rs_ = 0; rs_ < REP_SYNC; ++rs_) xcd_barrier(xbar); } while (0)
struct Args { const float* in[16]; float* out; unsigned char* ws; };

__global__ void __launch_bounds__(NWAVES * 64, 2) mega_fwd(Args args) {
    extern __shared__ __attribute__((aligned(16))) unsigned char lds_raw[];
    cg::grid_group grid = cg::this_grid();
    LAS unsigned char* lds = (LAS unsigned char*)lds_raw;
    const int tid = threadIdx.x, lane = tid & 63, wave = __builtin_amdgcn_readfirstlane(tid >> 6);
    const int G = gridDim.x, bx = blockIdx.x;
    const int gw = bx * NWAVES + wave, NGW = G * NWAVES;
    unsigned char* ws = args.ws;
    const float* x_in = args.in[0];
    float* xres = args.out;
    bf16* Hb = (bf16*)(ws + WS_H); bf16* MB = (bf16*)(ws + WS_MB); bf16* XR = (bf16*)(ws + WS_XR); float* LSE = (float*)(ws + WS_LSE);
    float* RS1 = (float*)(ws + WS_RS1); float* RS2 = (float*)(ws + WS_RS2); float* RS0 = (float*)(ws + WS_RS1 + 524288);
    bf16* Zb = (bf16*)(ws + WS_Z); bf16* MIX = (bf16*)(ws + WS_MIX); bf16* AB = (bf16*)(ws + WS_A);

    unsigned* barw = (unsigned*)(ws + WS_CTL);
    if (bx == 0) for (int i = tid; i < XCD_BAR_WORDS; i += NWAVES * 64) __hip_atomic_store(barw + i, 0u, __ATOMIC_RELAXED, __HIP_MEMORY_SCOPE_AGENT);
    if (tid < 2) ((volatile LAS unsigned*)(lds + XB_LDS_OFF))[tid] = 0u;
    for (int i = bx * (NWAVES * 64) + tid; i < 16 * 128 * 64; i += G * NWAVES * 64) __hip_atomic_store(barw + FX_CNT_WORD + i, 0u, __ATOMIC_RELAXED, __HIP_MEMORY_SCOPE_AGENT);
#ifndef REP_P0
#define REP_P0 1
#endif
    for (int rep_ = 0; rep_ < REP_P0; ++rep_) {
        LAS float* scr = (LAS float*)(lds + wave * 16384);
        constexpr int I_IN = (DM / 64) * (INW / 32), I_OUT = (DM / 64) * (DM / 32), I_F1 = (DM / 64) * (DFF / 32), I_F2 = (DFF / 64) * (DM / 32);
        constexpr int I_LAYER = I_IN + I_OUT + I_F1 + I_F2;
        for (int it = gw; it < DEPTH * I_LAYER; it += NGW) {
            const int l = it / I_LAYER; int r = it % I_LAYER;
            if (r < I_IN) { p0_transpose_item(args.in[5] + (size_t)l * DM * INW, DM, INW, (bf16*)(ws + WS_WIN) + (size_t)l * INW * DM, scr, r, lane, args.in[1] + l * DM); continue; } r -= I_IN;
            if (r < I_OUT) { p0_transpose_item(args.in[13] + (size_t)l * DM * DM, DM, DM, (bf16*)(ws + WS_WOUT) + (size_t)l * DM * DM, scr, r, lane, nullptr); continue; } r -= I_OUT;
            if (r < I_F1) { p0_transpose_item(args.in[14] + (size_t)l * DM * DFF, DM, DFF, (bf16*)(ws + WS_WFF1) + (size_t)l * DFF * DM, scr, r, lane, args.in[3] + l * DM); continue; } r -= I_F1;
            p0_transpose_item(args.in[15] + (size_t)l * DFF * DM, DFF, DM, (bf16*)(ws + WS_WFF2) + (size_t)l * DM * DFF, scr, r, lane, nullptr);
        }
        for (int i = bx * (NWAVES * 64) + tid; i < M; i += G * NWAVES * 64) RS0[i] = 1.0f;
        if (M % (4 * NGW) == 0) { for (int m = gw; m < M; m += 4 * NGW) rms_rows_to_bf16<4>(x_in, RS1, XR, m, NGW, lane); }
        else { for (int m = gw; m < M; m += NGW) rms_rows_to_bf16<1>(x_in, RS1, XR, m, NGW, lane); }
    }
    __syncthreads();
    grid.sync();
    XcdBarrier xbar = xcd_barrier_post(barw, (volatile LAS unsigned*)(lds + XB_LDS_OFF));

#ifdef PROBE_IDLE
    if (1) { const unsigned long long t0 = __builtin_amdgcn_s_memrealtime(); while (__builtin_amdgcn_s_memrealtime() - t0 < 50000ull) __builtin_amdgcn_s_sleep(64); }
#endif
    for (int l = 0; l < DEPTH; ++l) {
        {
            pg8::Gemm g{XR, (const bf16*)(ws + WS_WIN) + (size_t)l * INW * DM, M, INW, DM}; pg8::StaticOrder S; S.init(M, INW, G, bx);
            pg8::EpiBf16<0> E{Zb, INW, nullptr, AW, (size_t)AW, QSCALE, RS1, lds + XEPI_LDS_OFF, 0};
            pg8::gemm_phase<pg8::EpiBf16<0>, pg8::StaticOrder, PG8_ALIGN, PG8_SP2>(lds, g, S, E);
        }
        GSYNC();
#ifndef REP_MIX
#define REP_MIX 1
#endif
        for (int rep_ = 0; rep_ < REP_MIX; ++rep_) {
#ifndef REP_LRU
#define REP_LRU 1
#endif
            for (int rl_ = 0; rl_ < REP_LRU; ++rl_)
            for (int u0 = bx; u0 < NB * 8 * 4; u0 += G) { const int u = ((G & 7) == 0 && G == NB * 8 * 4) ? (u0 & 7) * (G >> 3) + (u0 >> 3) : u0;
                lru_unit(u, Zb, MIX, args.in[6] + (size_t)l * 4 * LW, args.in[7] + (size_t)l * LW, args.in[8] + (size_t)l * 8 * 64 * 64, args.in[9] + (size_t)l * LW,
                         args.in[10] + (size_t)l * 8 * 64 * 64, args.in[11] + (size_t)l * LW, args.in[12] + (size_t)l * LW, lds); }
            AttPre P = {};
#define ATT_UIDX(k) (((((k) * (G >> 3) + (bx >> 3)) / 48) * 8 + (bx & 7)) * 48 + (((k) * (G >> 3) + (bx >> 3)) % 48))
            const int nk = ((G & 7) == 0 && ATT_UNITS % G == 0) ? ATT_UNITS / G : 0;
            int u = nk ? ATT_UIDX(0) : bx;
            if (u < ATT_UNITS) att_issue(u, Zb, P);
            for (int k = 0; u < ATT_UNITS; ++k) {
                const int unext = nk ? ((k + 1 < nk) ? ATT_UIDX(k + 1) : ATT_UNITS) : u + G;
                __syncthreads();
                att_stage(P, lds);
                const u32x4 qa0 = P.q[0], qa1 = P.q[1], qb0 = P.q[2], qb1 = P.q[3];
                __syncthreads();
                if (unext < ATT_UNITS) att_issue(unext, Zb, P);
                att_compute(u, 0, qa0, qa1, ws, LSE, lds);
                att_compute(u, 1, qb0, qb1, ws, LSE, lds);
                u = unext;
            }
#undef ATT_UIDX
        }
        GSYNC();
#ifndef REP_CMB
#define REP_CMB 1
#endif
        for (int rc_ = 0; rc_ < REP_CMB; ++rc_) { int t_ = threadIdx.x; asm volatile("" : "+v"(t_)); att_combine(ws, LSE, MIX, bx * (NWAVES * 64) + t_, G * NWAVES * 64); }
        GSYNC();
        for (int rnd = 0; rnd < 2; ++rnd) {
            pg8::Gemm g{MIX, (const bf16*)(ws + WS_WOUT) + (size_t)l * DM * DM, M, DM, DM}; OneUnit S; S.base.init(M, DM, G, bx); S.round = rnd;
            unsigned* cb = barw + FX_CNT_WORD + ((l * 2 + 0) * 2) * 128 * 64;
            EpiRmsRes E{(l == 0) ? (const void*)x_in : (const void*)XR, (void*)XR, args.in[2] + l * DM, RS2, RowStats{(float*)(ws + WS_FX1), cb}, RowStats{(float*)(ws + WS_FX2), cb + 128 * 64}, (l == 0) ? 1 : 0, 0, (const float*)RS0, (const float*)RS0};
            pg8::gemm_phase<EpiRmsRes, OneUnit, false, PG8_SP2>(lds, g, S, E);
        }
        GSYNC();
#ifndef REP_G3
#define REP_G3 1
#endif
        for (int rep_ = 0; rep_ < REP_G3; ++rep_) {
            pg8::Gemm g{XR, (const bf16*)(ws + WS_WFF1) + (size_t)l * DFF * DM, M, DFF, DM}; pg8::StaticOrder S; S.init(M, DFF, G, bx);
            pg8::EpiBf16<2> E{AB, DFF, nullptr, 0, 0, 1.f, nullptr, lds + XEPI_LDS_OFF, 1};
            pg8::gemm_phase<pg8::EpiBf16<2>, pg8::StaticOrder, PG8_ALIGN, PG8_SP2>(lds, g, S, E);
        }
        GSYNC();
        for (int rnd = 0; rnd < 2; ++rnd) {
            pg8::Gemm g{AB, (const bf16*)(ws + WS_WFF2) + (size_t)l * DM * DFF, M, DM, DFF}; OneUnit S; S.base.init(M, DM, G, bx); S.round = rnd;
            unsigned* cb = barw + FX_CNT_WORD + ((l * 2 + 1) * 2) * 128 * 64;
            const int lastl = (l + 1 == DEPTH) ? 1 : 0;
            EpiRmsRes E{(const void*)XR, lastl ? (void*)xres : (void*)XR, args.in[4] + l * DM, RS1, RowStats{(float*)(ws + WS_FX1), cb}, RowStats{(float*)(ws + WS_FX2), cb + 128 * 64}, 0, lastl, (const float*)RS2, (const float*)RS0};
            pg8::gemm_phase<EpiRmsRes, OneUnit, false, PG8_SP2, true>(lds, g, S, E);
        }
        if (l + 1 < DEPTH) GSYNC();
    }
}

extern "C" void kernel_launch(void* const* d_in, const int* in_sizes, int n_in, void* d_out, int out_size, void* d_ws, size_t ws_size, hipStream_t stream) {
    static int grid = 0;
    if (grid == 0) {
        if (n_in != 16 || in_sizes[0] != M * DM || out_size != M * DM || ws_size < WS_END) { fprintf(stderr, "kernel_launch: unexpected shapes (n_in %d, in0 %d, out %d, ws %zu); nothing launched\n", n_in, n_in > 0 ? in_sizes[0] : -1, out_size, ws_size); grid = -1; return; }
        int dev = 0, cus = 0, per_cu = 0;
        if (hipGetDevice(&dev) != hipSuccess || hipDeviceGetAttribute(&cus, hipDeviceAttributeMultiprocessorCount, dev) != hipSuccess) { grid = -1; return; }
        if (hipFuncSetAttribute((const void*)mega_fwd, hipFuncAttributeMaxDynamicSharedMemorySize, LDS_BYTES) != hipSuccess) { fprintf(stderr, "kernel_launch: hipFuncSetAttribute failed\n"); grid = -1; return; }
        if (hipOccupancyMaxActiveBlocksPerMultiprocessor(&per_cu, (const void*)mega_fwd, NWAVES * 64, LDS_BYTES) != hipSuccess || per_cu < 1) { fprintf(stderr, "kernel_launch: occupancy query says %d\n", per_cu); per_cu = 1; }
        (void)hipGetLastError();
        grid = cus * per_cu;
    }
    if (grid < 0) return;
    Args a{};
    for (int i = 0; i < 16; ++i) a.in[i] = (const float*)d_in[i];
    a.out = (float*)d_out; a.ws = (unsigned char*)d_ws;
    void* kargs[] = {&a};
    hipError_t e = hipLaunchCooperativeKernel((const void*)mega_fwd, dim3(grid), dim3(NWAVES * 64), kargs, LDS_BYTES, stream);
    if (e != hipSuccess) fprintf(stderr, "kernel_launch: cooperative launch failed: %s (grid %d)\n", hipGetErrorString(e), grid);
}
```

```cpp
#include <hip/hip_runtime.h>
#include <hip/hip_cooperative_groups.h>
#include <cstdio>
#include <cstdint>
namespace cg = cooperative_groups;
namespace pg8 {
#define PG8_LAS __attribute__((address_space(3)))
typedef unsigned short bf16_t;
typedef short bf16x8 __attribute__((ext_vector_type(8)));
typedef float f32x4 __attribute__((ext_vector_type(4)));
typedef unsigned u32x4 __attribute__((ext_vector_type(4)));
constexpr int BM = 256, BK = 64, HALF = 128, HTB = HALF * BK * 2  , STAGE_BYTES = 8 * HTB, NXCD = 8, WGM = 8;

__host__ __device__ __forceinline__ int lds_byte(int r, int c) { const int st = (r >> 4) * 2 + (c >> 5), rr = r & 15, cc = c & 31, ob = rr * 64 + cc * 2; return st * 1024 + (ob ^ (((ob >> 9) & 1) << 5)); }
__host__ __device__ __forceinline__ void stage_rc(int b, int& R, int& C) { const int st = b / 1024, sb = b % 1024, swz = sb ^ (((sb >> 9) & 1) << 5); R = (st >> 1) * 16 + swz / 64; C = (st & 1) * 32 + (swz % 64) / 2; }
__host__ __device__ __forceinline__ int perm32(int rho) { const int n = rho >> 4, i = rho & 15; return 8 * (i >> 2) + 4 * n + (i & 3); }

struct Unit { int pm, pn; };
struct Gemm { const bf16_t* A; const bf16_t* Bt; int M, N, K; };

struct StaticOrder {
    int nM, nN, nwg, G, c;
    __host__ __device__ void init(int M, int N, int G_, int c_) { nM = M / BM; nN = N / BM; nwg = nM * nN; G = G_; c = c_; }
    __host__ __device__ bool next(int i, Unit& u) const {
        const long L = (long)i * G + c; if (L >= nwg) return false;
        int wgid = (int)L; { const int q = nwg / NXCD, r = nwg % NXCD, xcd = wgid % NXCD, off = wgid / NXCD; wgid = (xcd < r ? xcd * (q + 1) : r * (q + 1) + (xcd - r) * q) + off; }
        const int nig = WGM * nN, gid = wgid / nig, fm = gid * WGM, gsz = (nM - fm) < WGM ? (nM - fm) : WGM;
        u.pm = fm + ((wgid % nig) % gsz); u.pn = (wgid % nig) / gsz; return true;
    }
    __device__ __forceinline__ void a_ready(const Unit&) const {}
    __device__ __forceinline__ void done(const Unit&) const {}
};

__device__ __forceinline__ unsigned cvt_pk_bf16(float lo, float hi) { unsigned r; asm volatile("v_cvt_pk_bf16_f32 %0, %1, %2" : "=v"(r) : "v"(lo), "v"(hi)); return r; }
typedef float f32x2 __attribute__((ext_vector_type(2)));
__device__ __forceinline__ f32x2 gelu_pk(f32x2 v) {
    const f32x2 av = __builtin_elementwise_abs(v), d = av * 0.2316418882f + 1.0f;
    f32x2 t; t.x = __builtin_amdgcn_rcpf(d.x); t.y = __builtin_amdgcn_rcpf(d.y);
    f32x2 q = t * 0.5307027145f + (-0.7265760135f); q = q * t + 0.7107068705f; q = q * t + (-0.142248368f); q = q * t + 0.127414796f; q = q * t;
    const f32x2 s = (v * v) * (-0.72134752044f);
    f32x2 e; e.x = __builtin_amdgcn_exp2f(s.x); e.y = __builtin_amdgcn_exp2f(s.y);
    const f32x2 m = v * (q * e), r = v - m;
    f32x2 o; o.x = v.x < 0.f ? m.x : r.x; o.y = v.y < 0.f ? m.y : r.y; return o;
}

template <int ACT  > struct EpiBf16 {
    static constexpr bool PERM = true, AFTER_DRAIN = false; static_assert(ACT == 0 || ACT == 1 || ACT == 2, "EpiBf16: ACT is 0 (none), 1 (gelu_pk) or 2 (squared relu)");
    bf16_t* O; int ldc; const float* bias; int split_cols; size_t split_stride; float scale0; const float* rowscale; PG8_LAS unsigned char* xlds; int tiled;
    __device__ __forceinline__ void operator()(const f32x4 (&acc)[2][2][4][2], const Unit& u, int wr, int wc, int fr, int fq) const {
        const int row0 = u.pm * BM + wr * 64 + fr; int colt = u.pn * BM; bf16_t* base = O;
        float sc = 1.f; if (split_cols) { const int t = colt / split_cols; base += (size_t)t * split_stride; colt -= t * split_cols; if (t == 0) sc = scale0; }
        const int col0 = colt + wc * 64 + 8 * fq, bcol0 = u.pn * BM + wc * 64 + 8 * fq;
        const int lane_ = fq * 16 + fr; PG8_LAS unsigned char* xw = xlds ? xlds + (wr * 4 + wc) * 2048 : xlds;
        float rs8[8];
#pragma unroll
        for (int i = 0; i < 8; ++i) rs8[i] = rowscale ? rowscale[row0 + (i >> 2) * HALF + (i & 3) * 16] : 1.f;
        f32x4 bv[2][2];
#pragma unroll
        for (int bj = 0; bj < 2; ++bj)
#pragma unroll
            for (int n = 0; n < 2; ++n) bv[bj][n] = bias ? *(const f32x4*)(bias + bcol0 + bj * 32 + 4 * n) : (f32x4){0.f, 0.f, 0.f, 0.f};
#pragma unroll
        for (int ai = 0; ai < 2; ++ai)
#pragma unroll
            for (int m = 0; m < 4; ++m) { bf16_t* rowp = base + (size_t)(row0 + ai * HALF + m * 16) * ldc + col0; const float rsv = rs8[ai * 4 + m];
#pragma unroll
                for (int bj = 0; bj < 2; ++bj) { f32x4 v0 = (acc[ai][bj][m][0] + bv[bj][0]) * rsv, v1 = (acc[ai][bj][m][1] + bv[bj][1]) * rsv;
                    if (ACT == 1) { f32x2 a = gelu_pk((f32x2){v0[0], v0[1]}), b = gelu_pk((f32x2){v0[2], v0[3]}), c = gelu_pk((f32x2){v1[0], v1[1]}), d = gelu_pk((f32x2){v1[2], v1[3]});
                        v0 = (f32x4){a.x, a.y, b.x, b.y}; v1 = (f32x4){c.x, c.y, d.x, d.y}; }
                    if (ACT == 2) { _Pragma("unroll") for (int e = 0; e < 4; ++e) { const float p0 = __builtin_fmaxf(v0[e], 0.f), p1 = __builtin_fmaxf(v1[e], 0.f); v0[e] = p0 * p0; v1[e] = p1 * p1; } }
                    v0 = v0 * sc; v1 = v1 * sc; u32x4 w; w.x = cvt_pk_bf16(v0[0], v0[1]); w.y = cvt_pk_bf16(v0[2], v0[3]); w.z = cvt_pk_bf16(v1[0], v1[1]); w.w = cvt_pk_bf16(v1[2], v1[3]);
                    if (tiled) *(u32x4*)(base + ((size_t)((u.pm * BM + wr * 64 + ai * HALF + m * 16) >> 4) * (ldc >> 5) + ((colt + wc * 64 + bj * 32) >> 5)) * 512 + fr * 32 + 8 * fq) = w;
                    else if (xlds) *(PG8_LAS u32x4*)(xw + fr * 128 + (((bj * 4 + fq) ^ (fr & 7)) << 4)) = w;
                    else *(u32x4*)(rowp + bj * 32) = w; }
                if (xlds && !tiled) { asm volatile("s_waitcnt lgkmcnt(0)" ::: "memory");
                    bf16_t* gp = base + (size_t)(u.pm * BM + wr * 64 + ai * HALF + m * 16) * ldc + colt + wc * 64;
#pragma unroll
                    for (int hh = 0; hh < 2; ++hh) { const int rr = (lane_ >> 3) + 8 * hh, ch = lane_ & 7;
                        const u32x4 t = *(const PG8_LAS u32x4*)(xw + rr * 128 + ((ch ^ (rr & 7)) << 4));
                        *(u32x4*)(gp + (size_t)rr * ldc + ch * 8) = t; }
                    asm volatile("s_waitcnt lgkmcnt(0)" ::: "memory"); } }
    }
};
template <class Epi, class Sched, bool ALIGN_EPI = false, bool SP2 = false, bool ATILED = false>
__device__ __forceinline__ void gemm_phase(PG8_LAS unsigned char* lds, const Gemm g, const Sched& S, const Epi& E) {
    int tid_ = threadIdx.x; asm volatile("" : "+v"(tid_));
    const int tid = tid_, wid = __builtin_amdgcn_readfirstlane(tid >> 6), lane = tid & 63, wr = wid >> 2, wc = wid & 3, fr = lane & 15, fq = lane >> 4;
    const int K = g.K, nt = K / BK;
    unsigned voffA[2], voffB[2];
#pragma unroll
    for (int i = 0; i < 2; ++i) { int R, C; stage_rc(tid * 16 + i * 8192, R, C); const int Rb = Epi::PERM ? (64 * (R >> 5) + perm32(R & 31)) : R;
        voffA[i] = ATILED ? (unsigned)(((R >> 4) * (K >> 5) + (C >> 5)) * 1024 + (R & 15) * 64 + (C & 31) * 2) : (unsigned)(R * K + C) * 2u; voffB[i] = (unsigned)(Rb * K + C) * 2u; }
    const size_t kstep = (size_t)(BK * 2);
    const size_t kstepA = ATILED ? (size_t)2048 : kstep;
    const size_t hstep = (size_t)HALF * K * 2;
    const size_t hstepB = Epi::PERM ? (size_t)32 * K * 2 : hstep;
    const size_t tstep = 2 * hstep;
    const unsigned ldsw = (unsigned)wid * 1024u;
    const int aoff = lds_byte(wr * 64 + fr, fq * 8), boff = lds_byte(wc * 32 + fr, fq * 8);
#define PG8_SA(b, h) (((b) * 2 + (h)) * HTB)
#define PG8_SB(b, h) ((4 + (b) * 2 + (h)) * HTB)
#define PG8_STAGE(bufoff, gbase, voff) do { _Pragma("unroll") for (int _i = 0; _i < 2; ++_i) \
        __builtin_amdgcn_global_load_lds((const unsigned*)((const char*)(gbase) + (voff)[_i]), (PG8_LAS unsigned*)(lds + (bufoff) + ldsw + _i * 8192), 16, 0, 0); } while (0)
#define PG8_LDA(dst, b, h) do { _Pragma("unroll") for (int m = 0; m < 4; ++m) _Pragma("unroll") for (int k = 0; k < 2; ++k) dst[m][k] = *(const PG8_LAS bf16x8*)(lds + PG8_SA(b, h) + aoff + m * 2048 + k * 1024); } while (0)
#define PG8_LDB(dst, b, h) do { _Pragma("unroll") for (int n = 0; n < 2; ++n) _Pragma("unroll") for (int k = 0; k < 2; ++k) dst[n][k] = *(const PG8_LAS bf16x8*)(lds + PG8_SB(b, h) + boff + n * 2048 + k * 1024); } while (0)
#define PG8_MMA(ai, bj, At, Bt) do { __builtin_amdgcn_s_setprio(1); _Pragma("unroll") for (int m = 0; m < 4; ++m) _Pragma("unroll") for (int n = 0; n < 2; ++n) _Pragma("unroll") for (int k = 0; k < 2; ++k) \
        acc[ai][bj][m][n] = __builtin_amdgcn_mfma_f32_16x16x32_bf16(Bt[n][k], At[m][k], acc[ai][bj][m][n], 0, 0, 0); __builtin_amdgcn_s_setprio(0); } while (0)
#define PG8_WAIT_V(n) asm volatile("s_waitcnt vmcnt(" #n ")" ::: "memory")
#define PG8_WAIT_L(n) asm volatile("s_waitcnt lgkmcnt(" #n ")" ::: "memory")
#define PG8_BAR __builtin_amdgcn_s_barrier()
#define PG8_SCHED __builtin_amdgcn_sched_barrier(0)
    Unit cur, nxt; int ui = 0;
    if (!S.next(0, cur)) return;
    f32x4 acc[2][2][4][2];
#pragma unroll
    for (int a = 0; a < 2; ++a)
#pragma unroll
        for (int b = 0; b < 2; ++b)
#pragma unroll
            for (int m = 0; m < 4; ++m)
#pragma unroll
                for (int n = 0; n < 2; ++n) acc[a][b][m][n] = (f32x4){0.f, 0.f, 0.f, 0.f};
    bf16x8 At[4][2], B0[2][2], B1[2][2];
    const char* cA = (const char*)g.A + (size_t)cur.pm * tstep; const char* cB = (const char*)g.Bt + (size_t)cur.pn * tstep;
    S.a_ready(cur);
    if constexpr (SP2) {
        PG8_STAGE(PG8_SB(0, 0), cB, voffB); PG8_STAGE(PG8_SB(0, 1), cB + hstepB, voffB); PG8_STAGE(PG8_SA(0, 0), cA, voffA); PG8_STAGE(PG8_SA(0, 1), cA + hstep, voffA);
        if (wr == 1) PG8_BAR;
        PG8_WAIT_V(2); PG8_BAR;
        PG8_STAGE(PG8_SB(1, 0), cB + kstep, voffB); PG8_STAGE(PG8_SA(1, 0), cA + kstepA, voffA); PG8_STAGE(PG8_SB(1, 1), cB + hstepB + kstep, voffB);
        PG8_WAIT_V(6); PG8_BAR;
    } else {
        PG8_STAGE(PG8_SB(0, 0), cB, voffB); PG8_STAGE(PG8_SA(0, 0), cA, voffA); PG8_STAGE(PG8_SB(0, 1), cB + hstepB, voffB); PG8_STAGE(PG8_SA(0, 1), cA + hstep, voffA);
        if (wr == 1) PG8_BAR;
        PG8_WAIT_V(4); PG8_BAR;
        PG8_STAGE(PG8_SB(1, 0), cB + kstep, voffB); PG8_STAGE(PG8_SA(1, 0), cA + kstepA, voffA); PG8_STAGE(PG8_SB(1, 1), cB + hstepB + kstep, voffB);
        PG8_WAIT_V(6); PG8_BAR;
    }
    for (;;) {
        const bool has_next = S.next(ui + 1, nxt);
        const char* nA = has_next ? (const char*)g.A + (size_t)nxt.pm * tstep : cA; const char* nB = has_next ? (const char*)g.Bt + (size_t)nxt.pn * tstep : cB;
        for (int t = 0; t < nt; t += 2) {
            const bool last = (t == nt - 2);
            const char* a1 = cA + (size_t)(t + 1) * kstepA;
            const char* a2 = last ? nA : cA + (size_t)(t + 2) * kstepA; const char* b2 = last ? nB : cB + (size_t)(t + 2) * kstep;
            const char* a3 = a2 + kstepA; const char* b3 = b2 + kstep;
            if (last && has_next) S.a_ready(nxt);
            if constexpr (SP2) {
            PG8_LDB(B0, 0, 0); PG8_LDB(B1, 0, 1); PG8_SCHED; PG8_LDA(At, 0, 0); PG8_STAGE(PG8_SA(1, 1), a1 + hstep, voffA);
            PG8_WAIT_V(8); PG8_WAIT_L(0); PG8_BAR; PG8_MMA(0, 0, At, B0); PG8_MMA(0, 1, At, B1); PG8_BAR; PG8_SCHED;
            PG8_LDA(At, 0, 1); PG8_STAGE(PG8_SB(0, 0), b2, voffB); PG8_STAGE(PG8_SB(0, 1), b2 + hstepB, voffB); PG8_STAGE(PG8_SA(0, 0), a2, voffA);
            PG8_WAIT_V(8); PG8_WAIT_L(0); PG8_BAR; PG8_MMA(1, 0, At, B0); PG8_MMA(1, 1, At, B1); PG8_BAR; PG8_SCHED;
            PG8_LDB(B0, 1, 0); PG8_LDB(B1, 1, 1); PG8_SCHED; PG8_LDA(At, 1, 0); PG8_STAGE(PG8_SA(0, 1), a2 + hstep, voffA);
            PG8_WAIT_V(8); PG8_WAIT_L(0); PG8_BAR; PG8_MMA(0, 0, At, B0); PG8_MMA(0, 1, At, B1); PG8_BAR; PG8_SCHED;
            PG8_LDA(At, 1, 1); PG8_STAGE(PG8_SB(1, 0), b3, voffB); PG8_STAGE(PG8_SB(1, 1), b3 + hstepB, voffB); PG8_STAGE(PG8_SA(1, 0), a3, voffA);
            PG8_WAIT_V(8); PG8_WAIT_L(0); PG8_BAR; PG8_MMA(1, 0, At, B0); PG8_MMA(1, 1, At, B1); PG8_BAR; PG8_SCHED;
            } else {
            PG8_LDB(B0, 0, 0); PG8_SCHED; PG8_LDA(At, 0, 0); PG8_STAGE(PG8_SA(1, 1), a1 + hstep, voffA);
            PG8_WAIT_L(8); PG8_BAR; PG8_WAIT_L(0); PG8_MMA(0, 0, At, B0); PG8_BAR; PG8_SCHED;
            PG8_LDB(B1, 0, 1); PG8_STAGE(PG8_SB(0, 0), b2, voffB);
            PG8_BAR; PG8_WAIT_L(0); PG8_MMA(0, 1, At, B1); PG8_BAR;
            PG8_LDA(At, 0, 1); PG8_STAGE(PG8_SA(0, 0), a2, voffA);
            PG8_BAR; PG8_WAIT_L(0); PG8_MMA(1, 0, At, B0); PG8_BAR; PG8_SCHED;
            PG8_STAGE(PG8_SB(0, 1), b2 + hstepB, voffB);
            PG8_WAIT_V(6); PG8_BAR; PG8_MMA(1, 1, At, B1); PG8_BAR;
            PG8_LDB(B0, 1, 0); PG8_SCHED; PG8_LDA(At, 1, 0); PG8_STAGE(PG8_SA(0, 1), a2 + hstep, voffA);
            PG8_WAIT_L(8); PG8_BAR; PG8_WAIT_L(0); PG8_MMA(0, 0, At, B0); PG8_BAR; PG8_SCHED;
            PG8_LDB(B1, 1, 1); PG8_STAGE(PG8_SB(1, 0), b3, voffB);
            PG8_BAR; PG8_WAIT_L(0); PG8_MMA(0, 1, At, B1); PG8_BAR;
            PG8_LDA(At, 1, 1); PG8_STAGE(PG8_SA(1, 0), a3, voffA);
            PG8_BAR; PG8_WAIT_L(0); PG8_MMA(1, 0, At, B0); PG8_BAR; PG8_SCHED;
            PG8_STAGE(PG8_SB(1, 1), b3 + hstepB, voffB);
            PG8_WAIT_V(6); PG8_BAR; PG8_MMA(1, 1, At, B1); PG8_BAR;
            }
        }
        if constexpr (ALIGN_EPI) { if (wr == 0) PG8_BAR; }
        if constexpr (!Epi::AFTER_DRAIN) { E(acc, cur, wr, wc, fr, fq); S.done(cur); }
        if (!has_next) break;
#pragma unroll
        for (int a = 0; a < 2; ++a)
#pragma unroll
            for (int b = 0; b < 2; ++b)
#pragma unroll
                for (int m = 0; m < 4; ++m)
#pragma unroll
                    for (int n = 0; n < 2; ++n) acc[a][b][m][n] = (f32x4){0.f, 0.f, 0.f, 0.f};
        cur = nxt; cA = nA; cB = nB; ++ui;
        if constexpr (ALIGN_EPI) { if (wr == 1) PG8_BAR; }
    }
    PG8_WAIT_V(0);
    if constexpr (!ALIGN_EPI) { if (wr == 0) PG8_BAR; }
    PG8_BAR;
    if constexpr (Epi::AFTER_DRAIN) { E.fused(acc, cur, wr, wc, fr, fq, lds, wid, lane); S.done(cur); }
#undef PG8_SA
#undef PG8_SB
#undef PG8_STAGE
#undef PG8_LDA
#undef PG8_LDB
#undef PG8_MMA
#undef PG8_WAIT_V
#undef PG8_WAIT_L
#undef PG8_BAR
#undef PG8_SCHED
}
}

#ifndef PG8_SP2
#define PG8_SP2 true
#endif
#ifndef PG8_ALIGN
#define PG8_ALIGN true
#endif

constexpr int NB = 8, SEQ = 4096, DM = 1024, DEPTH = 4, NH = 8, HD = 64, AW = 512, LW = 512, INW = 2560, DFF = 4096;
constexpr int M = NB * SEQ;
constexpr float EPS = 1e-6f;
constexpr float QSCALE = 0.125f * 1.4426950408889634f;

constexpr size_t MiB = 1u << 20;
constexpr size_t WS_CTL = 0;
constexpr size_t WS_WIN = 1 * MiB, WS_WOUT = 21 * MiB, WS_WFF1 = 29 * MiB, WS_WFF2 = 61 * MiB;
constexpr size_t WS_H = 96 * MiB;
constexpr size_t WS_XR = 160 * MiB;
constexpr size_t WS_MB = 224 * MiB;
constexpr size_t WS_OP01 = 96 * MiB;
constexpr size_t WS_OP2 = 448 * MiB;
constexpr size_t WS_LSE = 480 * MiB;
constexpr size_t WS_Z = 224 * MiB;
constexpr size_t WS_MIX = 384 * MiB;
constexpr size_t WS_A = 224 * MiB;
constexpr size_t WS_RS1 = 484 * MiB;
constexpr size_t WS_RS2 = 484 * MiB + 262144;
constexpr size_t WS_FX1 = 485 * MiB, WS_FX2 = 485 * MiB + 524288;
constexpr size_t WS_END = 486 * MiB;
__device__ __forceinline__ unsigned short* op_base(unsigned char* ws, int p) { return (unsigned short*)(ws + (p == 2 ? WS_OP2 : WS_OP01 + (size_t)p * (32 * MiB))); }

constexpr int LDS_BYTES = 151552;
constexpr int XEPI_LDS_OFF = 133120;
constexpr int NWAVES = 8;

#define LAS __attribute__((address_space(3)))
typedef unsigned short bf16;
typedef short bf16x8 __attribute__((ext_vector_type(8)));
typedef short s16x4 __attribute__((ext_vector_type(4)));
typedef float f32x4 __attribute__((ext_vector_type(4)));
typedef unsigned u32x4 __attribute__((ext_vector_type(4)));
typedef unsigned u32x2 __attribute__((ext_vector_type(2)));

__device__ __forceinline__ unsigned f2bf(float f) { unsigned u = __builtin_bit_cast(unsigned, f); return (u + 0x7fffu + ((u >> 16) & 1u)) >> 16; }
typedef float f32x2_t __attribute__((ext_vector_type(2))); typedef __bf16 bf16x2_t __attribute__((ext_vector_type(2)));
__device__ __forceinline__ unsigned pk2(float lo, float hi) { f32x2_t v = {lo, hi}; bf16x2_t b = __builtin_convertvector(v, bf16x2_t); return __builtin_bit_cast(unsigned, b); }
__device__ __forceinline__ float bflo(unsigned w) { return __uint_as_float(w << 16); }
__device__ __forceinline__ float bfhi(unsigned w) { return __uint_as_float(w & 0xffff0000u); }
__device__ __forceinline__ float wave_sum(float v) {
#pragma unroll
    for (int o = 1; o < 64; o <<= 1) v += __shfl_xor(v, o);
    return v;
}

__device__ __forceinline__ void p0_transpose_item(const float* W, int K, int N, bf16* WT, LAS float* scr, int item, int lane, const float* gk) {
    const int nblk = N / 32, kb = item / nblk, nb = item % nblk, k0 = 64 * kb, n0 = 32 * nb;
    const int kl = lane >> 3, c4 = lane & 7;
    f32x4 v[8];
#pragma unroll
    for (int i = 0; i < 8; ++i) v[i] = *(const f32x4*)(W + (size_t)(k0 + 8 * i + kl) * N + n0 + 4 * c4);
#pragma unroll
    for (int i = 0; i < 8; ++i) { const float gv = gk ? gk[k0 + 8 * i + kl] : 1.f; LAS float* d = scr + (8 * i + kl) * 33 + 4 * c4; d[0] = v[i].x * gv; d[1] = v[i].y * gv; d[2] = v[i].z * gv; d[3] = v[i].w * gv; }
    asm volatile("s_waitcnt lgkmcnt(0)" ::: "memory");
    const int c = lane & 7;
#pragma unroll
    for (int j = 0; j < 4; ++j) { const int n = (lane >> 3) + 8 * j; const LAS float* s = scr + (8 * c) * 33 + n;
        u32x4 o; o.x = pk2(s[0 * 33], s[1 * 33]); o.y = pk2(s[2 * 33], s[3 * 33]); o.z = pk2(s[4 * 33], s[5 * 33]); o.w = pk2(s[6 * 33], s[7 * 33]);
        *(u32x4*)(WT + (size_t)(n0 + n) * K + k0 + 8 * c) = o; }
    asm volatile("s_waitcnt lgkmcnt(0)" ::: "memory");
}

template <int R> __device__ __forceinline__ void rms_rows_to_bf16(const float* x, float* rsout, bf16* out, int m0, int mstride, int lane) {
    f32x4 v[R][4]; float s[R];
#pragma unroll
    for (int r = 0; r < R; ++r)
#pragma unroll
        for (int j = 0; j < 4; ++j) v[r][j] = *((const f32x4*)(x + (size_t)(m0 + r * mstride) * DM) + lane + 64 * j);
#pragma unroll
    for (int r = 0; r < R; ++r) { float a = 0.f;
#pragma unroll
        for (int j = 0; j < 4; ++j) a += (v[r][j].x * v[r][j].x + v[r][j].y * v[r][j].y) + (v[r][j].z * v[r][j].z + v[r][j].w * v[r][j].w);
        s[r] = a; }
#pragma unroll
    for (int o = 1; o < 64; o <<= 1)
#pragma unroll
        for (int r = 0; r < R; ++r) s[r] += __shfl_xor(s[r], o);
#pragma unroll
    for (int r = 0; r < R; ++r) { if (lane == 0) rsout[m0 + r * mstride] = __builtin_amdgcn_rsqf(s[r] * (1.f / DM) + EPS);
        u32x2* o8 = (u32x2*)(out + (size_t)(m0 + r * mstride) * DM) + lane;
#pragma unroll
        for (int j = 0; j < 4; ++j) { u32x2 w; w.x = pk2(v[r][j].x, v[r][j].y); w.y = pk2(v[r][j].z, v[r][j].w); o8[64 * j] = w; } }
}

template <int R, bool XIN32, bool XOUT32> __device__ __forceinline__ void post_norm_rows(const bf16* mb, const void* xin, void* xout, const float* gpost, float* rsout, int m0, int mstride, int lane) {
    f32x4 xv[R][4]; u32x2 mw[R][4]; float s[R];
#pragma unroll
    for (int r = 0; r < R; ++r)
#pragma unroll
        for (int j = 0; j < 4; ++j) { const size_t ro = (size_t)(m0 + r * mstride) * DM; mw[r][j] = *((const u32x2*)(mb + ro) + lane + 64 * j);
            if (XIN32) xv[r][j] = *((const f32x4*)((const float*)xin + ro) + lane + 64 * j);
            else { const u32x2 w = *((const u32x2*)((const bf16*)xin + ro) + lane + 64 * j); xv[r][j] = (f32x4){bflo(w.x), bfhi(w.x), bflo(w.y), bfhi(w.y)}; } }
    f32x4 gg[4];
#pragma unroll
    for (int j = 0; j < 4; ++j) gg[j] = *((const f32x4*)gpost + lane + 64 * j);
#pragma unroll
    for (int r = 0; r < R; ++r) { float a = 0.f;
#pragma unroll
        for (int j = 0; j < 4; ++j) { const float a0 = bflo(mw[r][j].x), a1 = bfhi(mw[r][j].x), a2 = bflo(mw[r][j].y), a3 = bfhi(mw[r][j].y); a += (a0 * a0 + a1 * a1) + (a2 * a2 + a3 * a3); }
        s[r] = a; }
#pragma unroll
    for (int o = 1; o < 64; o <<= 1)
#pragma unroll
        for (int r = 0; r < R; ++r) s[r] += __shfl_xor(s[r], o);
#pragma unroll
    for (int r = 0; r < R; ++r) { const float rs = __builtin_amdgcn_rsqf(s[r] * (1.f / DM) + EPS); float a = 0.f; const size_t ro = (size_t)(m0 + r * mstride) * DM;
#pragma unroll
        for (int j = 0; j < 4; ++j) { const f32x4 mv = {bflo(mw[r][j].x), bfhi(mw[r][j].x), bflo(mw[r][j].y), bfhi(mw[r][j].y)};
            xv[r][j] = xv[r][j] + mv * rs * gg[j];
            if (XOUT32) *((f32x4*)((float*)xout + ro) + lane + 64 * j) = xv[r][j];
            else { u32x2 w; w.x = pk2(xv[r][j].x, xv[r][j].y); w.y = pk2(xv[r][j].z, xv[r][j].w); *((u32x2*)((bf16*)xout + ro) + lane + 64 * j) = w; }
            a += (xv[r][j].x * xv[r][j].x + xv[r][j].y * xv[r][j].y) + (xv[r][j].z * xv[r][j].z + xv[r][j].w * xv[r][j].w); }
        s[r] = a; }
    if (rsout) {
#pragma unroll
        for (int o = 1; o < 64; o <<= 1)
#pragma unroll
            for (int r = 0; r < R; ++r) s[r] += __shfl_xor(s[r], o);
#pragma unroll
        for (int r = 0; r < R; ++r) if (lane == 0) rsout[m0 + r * mstride] = __builtin_amdgcn_rsqf(s[r] * (1.f / DM) + EPS);
    }
}

constexpr int LRU_LDS_OFF = 98304;
constexpr int XB_LDS_OFF = 132096;
__device__ __forceinline__ float sigmoidf_(float x) { return __builtin_amdgcn_rcpf(1.0f + __builtin_amdgcn_exp2f(-1.4426950408889634f * x)); }
__device__ __forceinline__ float gelu_tanh(float g) { const float y2 = (2.0f * 0.7978845608028654f) * (g + 0.044715f * g * g * g); return g * sigmoidf_(y2); }

__device__ __forceinline__ void lru_unit(int unit, const bf16* Z, bf16* MIX, const float* conv_w, const float* conv_b, const float* w_r, const float* b_r,
                                         const float* w_i, const float* b_i, const float* lam, LAS unsigned char* lds) {
    const int qt = unit & 3, n = (unit >> 2) & 7, b = unit >> 5;
    int tid_ = threadIdx.x; asm volatile("" : "+v"(tid_));
    const int tid = tid_, lane = tid & 63, wid = __builtin_amdgcn_readfirstlane(tid >> 6), l15 = lane & 15, fq = lane >> 4;
    bf16x8 wd[4][2]; f32x4 cbv[4];
    bf16x8 wr[2], wi[2], wx[2];
#pragma unroll
    for (int ct = 0; ct < 4; ++ct) {
#pragma unroll
        for (int r = 0; r < 4; ++r) cbv[ct][r] = conv_b[64 * n + 16 * ct + 4 * fq + r];
#pragma unroll
        for (int ksp = 0; ksp < 2; ++ksp)
#pragma unroll
            for (int j = 0; j < 8; ++j) { const int tap = 2 * ksp + (fq >> 1), chl = 8 * (fq & 1) + j;
                wd[ct][ksp][j] = (chl == l15) ? (short)f2bf(conv_w[tap * LW + 64 * n + 16 * ct + chl]) : (short)0; }
    }
#pragma unroll
    for (int ks = 0; ks < 2; ++ks)
#pragma unroll
        for (int j = 0; j < 8; ++j) { const int sig = 16 * (2 * ks + (j >> 2)) + 4 * fq + (j & 3);
            wr[ks][j] = (short)f2bf(w_r[(size_t)(n * 64 + sig) * 64 + 16 * qt + l15]);
            wi[ks][j] = (short)f2bf(w_i[(size_t)(n * 64 + sig) * 64 + 16 * qt + l15]);
            wx[ks][j] = (sig == 16 * qt + l15) ? (short)0x3F80 : (short)0; }
    const int chan = 64 * n + 16 * qt + l15;
    const float br = b_r[chan], bi = b_i[chan], sp8 = -8.0f * log1pf(__expf(-lam[chan]));
    const bf16* Zb = Z + (size_t)b * SEQ * INW;
    bf16* Ob = MIX + (size_t)b * SEQ * DM + AW + chan;
    float hseg = 0.f;
    constexpr int XRP = 144;
    LAS unsigned char* xrw = lds + wid * (72 * XRP);
    const int lr8 = lane >> 3, lc8 = lane & 7;
    const bf16* Zx = Zb + 1536 + 64 * n + 8 * lc8;
    u32x4 nx[9];
#define LRU_ROWS(tbase) do { _Pragma("unroll") for (int g_ = 0; g_ < 9; ++g_) { int tr_ = (tbase) - 8 + 8 * g_ + lr8; tr_ = tr_ < 0 ? 0 : (tr_ > SEQ - 1 ? SEQ - 1 : tr_); nx[g_] = *(const u32x4*)(Zx + (size_t)tr_ * INW); } } while (0)
    LRU_ROWS(wid * 64);
    unsigned short grn[4][4];
#pragma unroll
    for (int mt = 0; mt < 4; ++mt)
#pragma unroll
        for (int r = 0; r < 4; ++r) grn[mt][r] = Zb[(size_t)(wid * 64 + 16 * mt + 4 * fq + r) * INW + 2048 + chan];
    for (int seg = 0; seg < 8; ++seg) {
        const int tw = seg * 512 + wid * 64;
        float Cel[4][4], Hel[4][4];
        unsigned short grv[4][4];
#pragma unroll
        for (int mt = 0; mt < 4; ++mt)
#pragma unroll
            for (int r = 0; r < 4; ++r) { grv[mt][r] = grn[mt][r]; const int tn = tw + 512 + 16 * mt + 4 * fq + r; grn[mt][r] = Zb[(size_t)(tn > SEQ - 1 ? SEQ - 1 : tn) * INW + 2048 + chan]; }
#pragma unroll
        for (int g = 0; g < 9; ++g) { u32x4 v = nx[g]; if (g == 0) { if (tw == 0) v = (u32x4){0u, 0u, 0u, 0u}; }
            *(LAS u32x4*)(xrw + (8 * g + lr8) * XRP + lc8 * 16) = v; }
        LRU_ROWS(tw + 512);
        float Cw = 1.f, Hw = 0.f;
#pragma unroll
        for (int mt = 0; mt < 4; ++mt) {
            const int t = tw + 16 * mt + l15;
            f32x4 accr = {0.f, 0.f, 0.f, 0.f}, acci = {0.f, 0.f, 0.f, 0.f}, accx = {0.f, 0.f, 0.f, 0.f};
            f32x4 cacc[4];
#pragma unroll
            for (int ct = 0; ct < 4; ++ct) {
                cacc[ct] = cbv[ct];
#pragma unroll
                for (int ksp = 0; ksp < 2; ++ksp) {
                    const u32x4 v = *(const LAS u32x4*)(xrw + (5 + 16 * mt + l15 + 2 * ksp + (fq >> 1)) * XRP + (16 * ct + 8 * (fq & 1)) * 2);
                    cacc[ct] = __builtin_amdgcn_mfma_f32_16x16x32_bf16(wd[ct][ksp], __builtin_bit_cast(bf16x8, v), cacc[ct], 0, 0, 0);
                }
            }
#pragma unroll
            for (int ks = 0; ks < 2; ++ks) {
                u32x4 ap; ap.x = pk2(cacc[2 * ks][0], cacc[2 * ks][1]); ap.y = pk2(cacc[2 * ks][2], cacc[2 * ks][3]);
                ap.z = pk2(cacc[2 * ks + 1][0], cacc[2 * ks + 1][1]); ap.w = pk2(cacc[2 * ks + 1][2], cacc[2 * ks + 1][3]);
                const bf16x8 a = __builtin_bit_cast(bf16x8, ap);
                accr = __builtin_amdgcn_mfma_f32_16x16x32_bf16(a, wr[ks], accr, 0, 0, 0);
                acci = __builtin_amdgcn_mfma_f32_16x16x32_bf16(a, wi[ks], acci, 0, 0, 0);
                accx = __builtin_amdgcn_mfma_f32_16x16x32_bf16(a, wx[ks], accx, 0, 0, 0);
            }
            float C[4], H[4];
#pragma unroll
            for (int r = 0; r < 4; ++r) {
                const float rg = sigmoidf_(accr[r] + br), ig = sigmoidf_(acci[r] + bi);
                const float la = sp8 * rg; const float a_ = __builtin_amdgcn_exp2f(1.4426950408889634f * la); const float mult = __builtin_amdgcn_sqrtf(fmaxf(1.0f - a_ * a_, 0.f));
                const float u_ = mult * ig * accx[r];
                if (r == 0) { C[0] = a_; H[0] = u_; } else { C[r] = a_ * C[r - 1]; H[r] = a_ * H[r - 1] + u_; }
            }
            float Ct = C[3], Ht = H[3];
            { const float Cp = __shfl_up(Ct, 16), Hp = __shfl_up(Ht, 16); if (fq >= 1) { Ht = Ct * Hp + Ht; Ct = Ct * Cp; } }
            { const float Cp = __shfl_up(Ct, 32), Hp = __shfl_up(Ht, 32); if (fq >= 2) { Ht = Ct * Hp + Ht; Ct = Ct * Cp; } }
            float Ce = __shfl_up(Ct, 16), He = __shfl_up(Ht, 16); if (fq == 0) { Ce = 1.f; He = 0.f; }
            const float Ctile = __shfl(Ct, 48 + l15), Htile = __shfl(Ht, 48 + l15);
            const float Cp = Cw * Ce, Hp = Ce * Hw + He;
#pragma unroll
            for (int r = 0; r < 4; ++r) { Cel[mt][r] = Cp * C[r]; Hel[mt][r] = C[r] * Hp + H[r]; }
            Hw = Ctile * Hw + Htile; Cw = Cw * Ctile;
        }
        LAS float* tot = (LAS float*)(lds + LRU_LDS_OFF) + (seg & 1) * 256;
        if (fq == 0) { tot[(wid * 16 + l15) * 2] = Cw; tot[(wid * 16 + l15) * 2 + 1] = Hw; }
        __syncthreads();
        float hin = hseg, hall = hseg;
#pragma unroll
        for (int w2 = 0; w2 < 8; ++w2) { const float c2 = tot[(w2 * 16 + l15) * 2], h2 = tot[(w2 * 16 + l15) * 2 + 1]; hall = c2 * hall + h2; if (w2 < wid) hin = hall; }
#pragma unroll
        for (int mt = 0; mt < 4; ++mt)
#pragma unroll
            for (int r = 0; r < 4; ++r) {
                const float hv = Cel[mt][r] * hin + Hel[mt][r];
                const float g = __uint_as_float((unsigned)grv[mt][r] << 16);
                Ob[(size_t)(tw + 16 * mt + 4 * fq + r) * DM] = (bf16)f2bf(hv * gelu_tanh(g));
            }
        hseg = hall;
    }
#undef LRU_ROWS
    __syncthreads();
}

constexpr int AT_PITCH = 160;
constexpr int AT_K = 0, AT_V = 384 * AT_PITCH;
constexpr int ATT_UNITS = NB * NH * 3 * 16;

struct AttPre { u32x4 k[6], v[6], q[4]; };
__device__ __forceinline__ void att_decode(int u, int& b, int& h, int& br, int& dsh, int& c, int& n2) {
    const int blk = u & 15, t = u >> 4; br = t % 3; const int bh = t / 3; h = bh & 7; b = bh >> 3; dsh = 2 * br; c = blk >> (4 - dsh); n2 = blk & ((16 >> dsh) - 1);
}
__device__ __forceinline__ void att_issue(int u, const bf16* Z, AttPre& P) {
    int b, h, br, dsh, c, n2; att_decode(u, b, h, br, dsh, c, n2);
    int tid_ = threadIdx.x; asm volatile("" : "+v"(tid_));
    const int tid = tid_, lane = tid & 63, wid = tid >> 6, l15 = lane & 15, fq = lane >> 4;
    const bf16* Zb = Z + (size_t)b * SEQ * INW + h * HD;
#pragma unroll
    for (int i = 0; i < 6; ++i) {
        const int id = tid + 512 * i, row = id >> 3, ch = id & 7; int tau = n2 * 256 - 128 + row; tau = tau < 0 ? 0 : tau;
        const bf16* p = Zb + (size_t)((tau << dsh) + c) * INW + ch * 8;
        P.k[i] = *(const u32x4*)(p + AW); P.v[i] = *(const u32x4*)(p + 2 * AW);
    }
#pragma unroll
    for (int blk = 0; blk < 2; ++blk) {
        const int posq = ((n2 * 256 + 128 * blk + 16 * wid + l15) << dsh) + c;
#pragma unroll
        for (int ks = 0; ks < 2; ++ks) P.q[2 * blk + ks] = *(const u32x4*)(Zb + (size_t)posq * INW + 32 * ks + 8 * fq);
    }
}
__device__ __forceinline__ void att_stage(const AttPre& P, LAS unsigned char* lds) {
    int tid_ = threadIdx.x; asm volatile("" : "+v"(tid_)); const int tid = tid_;
#pragma unroll
    for (int i = 0; i < 6; ++i) { const int id = tid + 512 * i, row = id >> 3, ch = id & 7;
        *(LAS u32x4*)(lds + AT_K + row * AT_PITCH + ch * 16) = P.k[i]; *(LAS u32x4*)(lds + AT_V + row * AT_PITCH + ch * 16) = P.v[i]; }
}
__device__ __forceinline__ s16x4 vtr(const LAS unsigned char* p) { return __builtin_bit_cast(s16x4, __builtin_amdgcn_ds_read_tr16_b64_v4i16((LAS s16x4*)p)); }

__device__ __forceinline__ void att_compute(int u, int blk, const u32x4& qf0, const u32x4& qf1, unsigned char* ws, float* LSE, LAS unsigned char* lds) {
    int b, h, br, dsh, c, n2; att_decode(u, b, h, br, dsh, c, n2); const int n = 2 * n2 + blk;
    int tid_ = threadIdx.x; asm volatile("" : "+v"(tid_));
    const int tid = tid_, lane = tid & 63, wid = __builtin_amdgcn_readfirstlane(tid >> 6), l15 = lane & 15, fq = lane >> 4;
    const bf16x8 q0 = __builtin_bit_cast(bf16x8, qf0), q1 = __builtin_bit_cast(bf16x8, qf1);
    f32x4 s[9];
    const LAS unsigned char* kb = lds + AT_K + (128 * blk + 16 * wid + l15) * AT_PITCH + fq * 16;
#pragma unroll
    for (int j = 0; j < 9; ++j) {
        const bf16x8 a0 = *(const LAS bf16x8*)(kb + j * 16 * AT_PITCH), a1 = *(const LAS bf16x8*)(kb + j * 16 * AT_PITCH + 64);
        f32x4 acc = {0.f, 0.f, 0.f, 0.f};
        acc = __builtin_amdgcn_mfma_f32_16x16x32_bf16(a0, q0, acc, 0, 0, 0);
        acc = __builtin_amdgcn_mfma_f32_16x16x32_bf16(a1, q1, acc, 0, 0, 0);
        s[j] = acc;
    }
    const float NEG = -INFINITY;
#pragma unroll
    for (int r = 0; r < 4; ++r) { const int dlt = 4 * fq + r - l15; if (dlt < 0) s[0][r] = NEG; if (dlt > 0) s[8][r] = NEG; }
    if (n == 0) {
#pragma unroll
        for (int j = 0; j < 8; ++j) if (wid + j < 8) s[j] = (f32x4){NEG, NEG, NEG, NEG};
    }
    float m = NEG;
#pragma unroll
    for (int j = 0; j < 9; ++j) m = fmaxf(m, fmaxf(fmaxf(s[j][0], s[j][1]), fmaxf(s[j][2], s[j][3])));
    m = fmaxf(m, __shfl_xor(m, 16)); m = fmaxf(m, __shfl_xor(m, 32));
    float l = 0.f;
#pragma unroll
    for (int j = 0; j < 9; ++j)
#pragma unroll
        for (int r = 0; r < 4; ++r) { const float p = __builtin_amdgcn_exp2f(s[j][r] - m); s[j][r] = p; l += p; }
    l += __shfl_xor(l, 16); l += __shfl_xor(l, 32);
    bf16x8 pb[5];
#pragma unroll
    for (int pr = 0; pr < 5; ++pr) {
        u32x4 w; w.x = pk2(s[2 * pr][0], s[2 * pr][1]); w.y = pk2(s[2 * pr][2], s[2 * pr][3]);
        if (pr < 4) { w.z = pk2(s[2 * pr + 1][0], s[2 * pr + 1][1]); w.w = pk2(s[2 * pr + 1][2], s[2 * pr + 1][3]); } else { w.z = 0u; w.w = 0u; }
        pb[pr] = __builtin_bit_cast(bf16x8, w);
    }
    const LAS unsigned char* vb = lds + AT_V + (128 * blk + 16 * wid + 4 * fq + (l15 >> 2)) * AT_PITCH + (l15 & 3) * 8;
    f32x4 o[4];
#pragma unroll
    for (int dt = 0; dt < 4; ++dt) {
        f32x4 acc = {0.f, 0.f, 0.f, 0.f};
#pragma unroll
        for (int pr = 0; pr < 5; ++pr) {
            const s16x4 lo = vtr(vb + (2 * pr) * 16 * AT_PITCH + dt * 32);
            s16x4 hi = {0, 0, 0, 0};
            if (pr < 4) hi = vtr(vb + (2 * pr + 1) * 16 * AT_PITCH + dt * 32);
            const bf16x8 a = {lo[0], lo[1], lo[2], lo[3], hi[0], hi[1], hi[2], hi[3]};
            acc = __builtin_amdgcn_mfma_f32_16x16x32_bf16(a, pb[pr], acc, 0, 0, 0);
        }
        o[dt] = acc;
    }
    const float inv = __builtin_amdgcn_rcpf(l);
    const int posq = ((n * 128 + 16 * wid + l15) << dsh) + c;
    const size_t row = (size_t)b * SEQ + posq;
    bf16* op = op_base(ws, br) + row * AW + h * HD + 4 * fq;
#pragma unroll
    for (int dt = 0; dt < 4; ++dt) { u32x2 w; w.x = pk2(o[dt][0] * inv, o[dt][1] * inv); w.y = pk2(o[dt][2] * inv, o[dt][3] * inv); *(u32x2*)(op + 16 * dt) = w; }
    if (fq == 0) LSE[((size_t)br * M + row) * NH + h] = m + __builtin_amdgcn_logf(l);
}

__device__ __forceinline__ void att_combine(unsigned char* ws, const float* LSE, bf16* MIX, int gtid, int gthreads) {
    for (int id = gtid; id < M * 64; id += gthreads) {
        const int row = id >> 6, ch = id & 63, h = ch >> 3;
        float L[3];
#pragma unroll
        for (int p = 0; p < 3; ++p) L[p] = LSE[((size_t)p * M + row) * NH + h];
        const float mx = fmaxf(L[0], fmaxf(L[1], L[2]));
        float w[3]; float sw = 0.f;
#pragma unroll
        for (int p = 0; p < 3; ++p) { w[p] = __builtin_amdgcn_exp2f(L[p] - mx); sw += w[p]; }
        const float isw = __builtin_amdgcn_rcpf(sw);
        float acc[8] = {0.f, 0.f, 0.f, 0.f, 0.f, 0.f, 0.f, 0.f};
#pragma unroll
        for (int p = 0; p < 3; ++p) { const u32x4 v = *(const u32x4*)(op_base(ws, p) + (size_t)row * AW + ch * 8); const float ww = w[p] * isw;
            acc[0] += ww * bflo(v.x); acc[1] += ww * bfhi(v.x); acc[2] += ww * bflo(v.y); acc[3] += ww * bfhi(v.y);
            acc[4] += ww * bflo(v.z); acc[5] += ww * bfhi(v.z); acc[6] += ww * bflo(v.w); acc[7] += ww * bfhi(v.w); }
        u32x4 o; o.x = pk2(acc[0], acc[1]); o.y = pk2(acc[2], acc[3]); o.z = pk2(acc[4], acc[5]); o.w = pk2(acc[6], acc[7]);
        *(u32x4*)(MIX + (size_t)row * DM + ch * 8) = o;
    }
}

#define XB_TMO      128
#define XB_XCNT(j)  (256  + 64 * (j))
#define XB_XSUB(j)  (1280 + 64 * (j))
#define XB_XGEN(j)  (2304 + 64 * (j))
#define XB_TOP      3328
#define XB_TOPGEN   3392
#define XCD_BAR_WORDS 3456
#define XB_SPIN_CAP (1u << 18)

__device__ __forceinline__ unsigned xb_ld(unsigned* p)              { return __hip_atomic_load(p, __ATOMIC_RELAXED, __HIP_MEMORY_SCOPE_AGENT); }
__device__ __forceinline__ unsigned xb_add(unsigned* p, unsigned v) { return __hip_atomic_fetch_add(p, v, __ATOMIC_RELAXED, __HIP_MEMORY_SCOPE_AGENT); }
__device__ __forceinline__ unsigned xb_xcc_id() { return (unsigned)__builtin_amdgcn_s_getreg((3 << 11) | 20) & 0xFu; }
#define XB_SPIN(cond, bar) do { unsigned _sp = 0; while (cond) { __builtin_amdgcn_s_sleep(1); \
    if ((++_sp & 255u) == 0u) { if (xb_ld(&(bar)[XB_TMO])) break; if (_sp > XB_SPIN_CAP) { atomicAdd(&(bar)[XB_TMO], 1u); break; } } } } while (0)

struct XcdBarrier {
    unsigned* bar; unsigned x;
    volatile LAS unsigned* st;
};

__device__ __forceinline__ XcdBarrier xcd_barrier_post(unsigned* bar, volatile LAS unsigned* st) {
    XcdBarrier b; b.bar = bar; b.x = xb_xcc_id(); b.st = st;
    if (threadIdx.x == 0) (void)xb_add(&bar[XB_XCNT(b.x)], 1u);
    return b;
}
__device__ __forceinline__ void xcd_barrier_complete(unsigned* bar, unsigned x, unsigned& nloc, unsigned& nx) {
    const unsigned G = gridDim.x * gridDim.y * gridDim.z;
    unsigned sum, cnt, mine, sp = 0u;
    for (;;) {
        sum = 0u; cnt = 0u; mine = 0u;
#pragma unroll
        for (unsigned j = 0; j < 16; ++j) { const unsigned c = xb_ld(&bar[XB_XCNT(j)]); sum += c; cnt += (c > 0u) ? 1u : 0u; mine = (j == x) ? c : mine; }
        if (sum == G) break;
        __builtin_amdgcn_s_sleep(1);
        if ((++sp & 255u) == 0u) { if (xb_ld(&bar[XB_TMO])) break; if (sp > XB_SPIN_CAP) { atomicAdd(&bar[XB_TMO], 1u); break; } }
    }
    nloc = mine > 0u ? mine : 1u; nx = cnt > 0u ? cnt : 1u;
}

__device__ __forceinline__ void xcd_barrier(const XcdBarrier& b) {
    asm volatile("s_waitcnt vmcnt(0)" ::: "memory");
    __syncthreads();
    if (threadIdx.x == 0) {
        unsigned* bar = b.bar;
        __builtin_amdgcn_s_waitcnt(0);
        unsigned nloc = b.st[0], nx = b.st[1];
        if (nloc == 0u) { xcd_barrier_complete(bar, b.x, nloc, nx); b.st[0] = nloc; b.st[1] = nx; }
        const unsigned old = xb_add(&bar[XB_XSUB(b.x)], 1u);
        const unsigned gen = old / nloc;
        if (old + 1u == (gen + 1u) * nloc) {
            __builtin_amdgcn_fence(__ATOMIC_RELEASE, "agent");
            asm volatile("s_waitcnt vmcnt(0)" ::: "memory");
            const unsigned og = xb_add(&bar[XB_TOP], 1u);
            const unsigned tg = og / nx;
            if (og + 1u == (tg + 1u) * nx) xb_add(&bar[XB_TOPGEN], 1u);
            else XB_SPIN(xb_ld(&bar[XB_TOPGEN]) == tg, bar);
            __builtin_amdgcn_fence(__ATOMIC_ACQUIRE, "agent");
            xb_add(&bar[XB_XGEN(b.x)], 1u);
            asm volatile("s_waitcnt vmcnt(0)" ::: "memory");
        } else {
            XB_SPIN(xb_ld(&bar[XB_XGEN(b.x)]) == gen, bar);
            __builtin_amdgcn_fence(__ATOMIC_ACQUIRE, "agent");
            asm volatile("s_waitcnt vmcnt(0)" ::: "memory");
        }
    }
    __syncthreads();
}


constexpr int FX_CNT_WORD = 16384;
struct RowStats {
    float* slots;
    unsigned* cnt;
    __device__ __forceinline__ void run(const pg8::f32x4 (&v)[2][2][4][2], const pg8::Unit& u, int wr, int wc, int fr, int fq, LAS unsigned char* lds, int wid, int lane, const float* rprev) const {
        LAS float* P = (LAS float*)lds;
        LAS float* S = (LAS float*)(lds + 8192);
#pragma unroll
        for (int ai = 0; ai < 2; ++ai)
#pragma unroll
            for (int mm = 0; mm < 4; ++mm) {
                float s = 0.f;
#pragma unroll
                for (int bj = 0; bj < 2; ++bj)
#pragma unroll
                    for (int n = 0; n < 2; ++n) { const pg8::f32x4 x = v[ai][bj][mm][n]; s += (x[0] * x[0] + x[1] * x[1]) + (x[2] * x[2] + x[3] * x[3]); }
                s += __shfl_xor(s, 16); s += __shfl_xor(s, 32);
                if (fq == 0) P[(ai * 128 + wr * 64 + mm * 16 + fr) * 4 + wc] = s;
            }
        asm volatile("s_waitcnt lgkmcnt(0)" ::: "memory"); __builtin_amdgcn_s_barrier(); asm volatile("" ::: "memory");
        const int row = wid * 32 + (lane & 31);
        const float pr = rprev[u.pm * 256 + row];
        if (lane < 32) {
            const float t = (P[row * 4 + 0] + P[row * 4 + 1]) + (P[row * 4 + 2] + P[row * 4 + 3]);
            __hip_atomic_store(slots + ((size_t)(u.pm * 256 + row) * 4 + u.pn), t, __ATOMIC_RELAXED, __HIP_MEMORY_SCOPE_AGENT);
        }
        asm volatile("s_waitcnt vmcnt(0)" ::: "memory");
        if (lane == 0) __hip_atomic_fetch_add(cnt + 64 * u.pm, 1u, __ATOMIC_RELAXED, __HIP_MEMORY_SCOPE_AGENT);
        if (wid == 0) { unsigned sp = 0;
            while ((unsigned)__builtin_amdgcn_readfirstlane(__hip_atomic_load(cnt + 64 * u.pm, __ATOMIC_RELAXED, __HIP_MEMORY_SCOPE_AGENT)) < 32u && ++sp < (1u << 22)) __builtin_amdgcn_s_sleep(1); }
        asm volatile("s_waitcnt vmcnt(0) lgkmcnt(0)" ::: "memory"); __builtin_amdgcn_s_barrier(); asm volatile("" ::: "memory");
        if (lane < 32) {
            const float* sl = slots + (size_t)(u.pm * 256 + row) * 4; float t = 0.f;
#pragma unroll
            for (int k = 0; k < 4; ++k) t += __hip_atomic_load(sl + k, __ATOMIC_RELAXED, __HIP_MEMORY_SCOPE_AGENT);
            const float p2 = pr * pr; S[row] = t * (1.f / DM) + EPS * __builtin_amdgcn_rcpf(p2 * p2);
        }
        asm volatile("s_waitcnt vmcnt(0) lgkmcnt(0)" ::: "memory"); __builtin_amdgcn_s_barrier(); asm volatile("" ::: "memory");
    }
};
struct EpiRmsRes {
    static constexpr bool PERM = true, AFTER_DRAIN = true;
    const void* xin; void* xout; const float* gpost; float* rsout; RowStats st1, st2; int xin32, last; const float* rsprev; const float* ones;
    __device__ __forceinline__ void fused(pg8::f32x4 (&acc)[2][2][4][2], const pg8::Unit& u, int wr, int wc, int fr, int fq, LAS unsigned char* lds, int wid, int lane) const {
        const LAS float* S = (const LAS float*)(lds + 8192);
        const int col0 = u.pn * 256 + wc * 64 + 8 * fq;
        u32x4 xpre[2][4][2];
        if (!xin32) {
#pragma unroll
            for (int ai = 0; ai < 2; ++ai)
#pragma unroll
                for (int mm = 0; mm < 4; ++mm) { const size_t off = (size_t)(u.pm * 256 + ai * 128 + wr * 64 + mm * 16 + fr) * DM + col0;
#pragma unroll
                    for (int bj = 0; bj < 2; ++bj) xpre[ai][mm][bj] = *(const u32x4*)((const bf16*)xin + off + bj * 32); }
        }
        st1.run(acc, u, wr, wc, fr, fq, lds, wid, lane, rsprev);
        pg8::f32x4 gv[2][2];
#pragma unroll
        for (int bj = 0; bj < 2; ++bj)
#pragma unroll
            for (int n = 0; n < 2; ++n) gv[bj][n] = *(const pg8::f32x4*)(gpost + col0 + bj * 32 + n * 4);
#pragma unroll
        for (int ai = 0; ai < 2; ++ai)
#pragma unroll
            for (int mm = 0; mm < 4; ++mm) {
                const int r = ai * 128 + wr * 64 + mm * 16 + fr; const float rs = __builtin_amdgcn_rsqf(S[r]);
                const size_t off = (size_t)(u.pm * 256 + r) * DM + col0;
#pragma unroll
                for (int bj = 0; bj < 2; ++bj) {
                    pg8::f32x4 xa, xb;
                    if (xin32) { xa = *(const pg8::f32x4*)((const float*)xin + off + bj * 32); xb = *(const pg8::f32x4*)((const float*)xin + off + bj * 32 + 4); }
                    else { const u32x4 w = xpre[ai][mm][bj]; xa = (pg8::f32x4){bflo(w.x), bfhi(w.x), bflo(w.y), bfhi(w.y)}; xb = (pg8::f32x4){bflo(w.z), bfhi(w.z), bflo(w.w), bfhi(w.w)}; }
                    const pg8::f32x4 ya = xa + acc[ai][bj][mm][0] * rs * gv[bj][0], yb = xb + acc[ai][bj][mm][1] * rs * gv[bj][1];
                    acc[ai][bj][mm][0] = ya; acc[ai][bj][mm][1] = yb;
                    if (last) { *(pg8::f32x4*)((float*)xout + off + bj * 32) = ya; *(pg8::f32x4*)((float*)xout + off + bj * 32 + 4) = yb; }
                    else { u32x4 w; w.x = pk2(ya[0], ya[1]); w.y = pk2(ya[2], ya[3]); w.z = pk2(yb[0], yb[1]); w.w = pk2(yb[2], yb[3]); *(u32x4*)((bf16*)xout + off + bj * 32) = w; }
                }
                if (mm & 1) asm volatile("" ::: "memory");
            }
        if (!last) {
            st2.run(acc, u, wr, wc, fr, fq, lds, wid, lane, ones);
            if (u.pn == 0 && wc == 0 && fq == 0) {
#pragma unroll
                for (int ai = 0; ai < 2; ++ai)
#pragma unroll
                    for (int mm = 0; mm < 4; ++mm) { const int r = ai * 128 + wr * 64 + mm * 16 + fr; rsout[u.pm * 256 + r] = __builtin_amdgcn_rsqf(S[r]); }
            }
        }
        asm volatile("s_waitcnt lgkmcnt(0)" ::: "memory"); __builtin_amdgcn_s_barrier(); asm volatile("" ::: "memory");
    }
};
struct OneUnit {
    pg8::StaticOrder base; int round;
    __device__ __forceinline__ bool next(int i, pg8::Unit& u) const { return i == 0 && base.next(round, u); }
    __device__ __forceinline__ void a_ready(const pg8::Unit&) const {}
    __device__ __forceinline__ void done(const pg8::Unit&) const {}
};

#ifndef REP_SYNC
#define REP_SYNC 1
#endif
#define GSYNC() do { for (int rs_ = 0; rs_ < REP_SYNC; ++rs_) xcd_barrier(xbar); } while (0)
struct Args { const float* in[16]; float* out; unsigned char* ws; };

__global__ void __launch_bounds__(NWAVES * 64, 2) mega_fwd(Args args) {
    extern __shared__ __attribute__((aligned(16))) unsigned char lds_raw[];
    cg::grid_group grid = cg::this_grid();
    LAS unsigned char* lds = (LAS unsigned char*)lds_raw;
    const int tid = threadIdx.x, lane = tid & 63, wave = __builtin_amdgcn_readfirstlane(tid >> 6);
    const int G = gridDim.x, bx = blockIdx.x;
    const int gw = bx * NWAVES + wave, NGW = G * NWAVES;
    unsigned char* ws = args.ws;
    const float* x_in = args.in[0];
    float* xres = args.out;
    bf16* Hb = (bf16*)(ws + WS_H); bf16* MB = (bf16*)(ws + WS_MB); bf16* XR = (bf16*)(ws + WS_XR); float* LSE = (float*)(ws + WS_LSE);
    float* RS1 = (float*)(ws + WS_RS1); float* RS2 = (float*)(ws + WS_RS2); float* RS0 = (float*)(ws + WS_RS1 + 524288);
    bf16* Zb = (bf16*)(ws + WS_Z); bf16* MIX = (bf16*)(ws + WS_MIX); bf16* AB = (bf16*)(ws + WS_A);

    unsigned* barw = (unsigned*)(ws + WS_CTL);
    if (bx == 0) for (int i = tid; i < XCD_BAR_WORDS; i += NWAVES * 64) __hip_atomic_store(barw + i, 0u, __ATOMIC_RELAXED, __HIP_MEMORY_SCOPE_AGENT);
    if (tid < 2) ((volatile LAS unsigned*)(lds + XB_LDS_OFF))[tid] = 0u;
    for (int i = bx * (NWAVES * 64) + tid; i < 16 * 128 * 64; i += G * NWAVES * 64) __hip_atomic_store(barw + FX_CNT_WORD + i, 0u, __ATOMIC_RELAXED, __HIP_MEMORY_SCOPE_AGENT);
#ifndef REP_P0
#define REP_P0 1
#endif
    for (int rep_ = 0; rep_ < REP_P0; ++rep_) {
        LAS float* scr = (LAS float*)(lds + wave * 16384);
        constexpr int I_IN = (DM / 64) * (INW / 32), I_OUT = (DM / 64) * (DM / 32), I_F1 = (DM / 64) * (DFF / 32), I_F2 = (DFF / 64) * (DM / 32);
        constexpr int I_LAYER = I_IN + I_OUT + I_F1 + I_F2;
        for (int it = gw; it < DEPTH * I_LAYER; it += NGW) {
            const int l = it / I_LAYER; int r = it % I_LAYER;
            if (r < I_IN) { p0_transpose_item(args.in[5] + (size_t)l * DM * INW, DM, INW, (bf16*)(ws + WS_WIN) + (size_t)l * INW * DM, scr, r, lane, args.in[1] + l * DM); continue; } r -= I_IN;
            if (r < I_OUT) { p0_transpose_item(args.in[13] + (size_t)l * DM * DM, DM, DM, (bf16*)(ws + WS_WOUT) + (size_t)l * DM * DM, scr, r, lane, nullptr); continue; } r -= I_OUT;
            if (r < I_F1) { p0_transpose_item(args.in[14] + (size_t)l * DM * DFF, DM, DFF, (bf16*)(ws + WS_WFF1) + (size_t)l * DFF * DM, scr, r, lane, args.in[3] + l * DM); continue; } r -= I_F1;
            p0_transpose_item(args.in[15] + (size_t)l * DFF * DM, DFF, DM, (bf16*)(ws + WS_WFF2) + (size_t)l * DM * DFF, scr, r, lane, nullptr);
        }
        for (int i = bx * (NWAVES * 64) + tid; i < M; i += G * NWAVES * 64) RS0[i] = 1.0f;
        if (M % (4 * NGW) == 0) { for (int m = gw; m < M; m += 4 * NGW) rms_rows_to_bf16<4>(x_in, RS1, XR, m, NGW, lane); }
        else { for (int m = gw; m < M; m += NGW) rms_rows_to_bf16<1>(x_in, RS1, XR, m, NGW, lane); }
    }
    __syncthreads();
    grid.sync();
    XcdBarrier xbar = xcd_barrier_post(barw, (volatile LAS unsigned*)(lds + XB_LDS_OFF));

#ifdef PROBE_IDLE
    if (1) { const unsigned long long t0 = __builtin_amdgcn_s_memrealtime(); while (__builtin_amdgcn_s_memrealtime() - t0 < 50000ull) __builtin_amdgcn_s_sleep(64); }
#endif
    for (int l = 0; l < DEPTH; ++l) {
        {
            pg8::Gemm g{XR, (const bf16*)(ws + WS_WIN) + (size_t)l * INW * DM, M, INW, DM}; pg8::StaticOrder S; S.init(M, INW, G, bx);
            pg8::EpiBf16<0> E{Zb, INW, nullptr, AW, (size_t)AW, QSCALE, RS1, lds + XEPI_LDS_OFF, 0};
            pg8::gemm_phase<pg8::EpiBf16<0>, pg8::StaticOrder, PG8_ALIGN, PG8_SP2>(lds, g, S, E);
        }
        GSYNC();
#ifndef REP_MIX
#define REP_MIX 1
#endif
        for (int rep_ = 0; rep_ < REP_MIX; ++rep_) {
#ifndef REP_LRU
#define REP_LRU 1
#endif
            for (int rl_ = 0; rl_ < REP_LRU; ++rl_)
            for (int u0 = bx; u0 < NB * 8 * 4; u0 += G) { const int u = ((G & 7) == 0 && G == NB * 8 * 4) ? (u0 & 7) * (G >> 3) + (u0 >> 3) : u0;
                lru_unit(u, Zb, MIX, args.in[6] + (size_t)l * 4 * LW, args.in[7] + (size_t)l * LW, args.in[8] + (size_t)l * 8 * 64 * 64, args.in[9] + (size_t)l * LW,
                         args.in[10] + (size_t)l * 8 * 64 * 64, args.in[11] + (size_t)l * LW, args.in[12] + (size_t)l * LW, lds); }
            AttPre P = {};
#define ATT_UIDX(k) (((((k) * (G >> 3) + (bx >> 3)) / 48) * 8 + (bx & 7)) * 48 + (((k) * (G >> 3) + (bx >> 3)) % 48))
            const int nk = ((G & 7) == 0 && ATT_UNITS % G == 0) ? ATT_UNITS / G : 0;
            int u = nk ? ATT_UIDX(0) : bx;
            if (u < ATT_UNITS) att_issue(u, Zb, P);
            for (int k = 0; u < ATT_UNITS; ++k) {
                const int unext = nk ? ((k + 1 < nk) ? ATT_UIDX(k + 1) : ATT_UNITS) : u + G;
                __syncthreads();
                att_stage(P, lds);
                const u32x4 qa0 = P.q[0], qa1 = P.q[1], qb0 = P.q[2], qb1 = P.q[3];
                __syncthreads();
                if (unext < ATT_UNITS) att_issue(unext, Zb, P);
                att_compute(u, 0, qa0, qa1, ws, LSE, lds);
                att_compute(u, 1, qb0, qb1, ws, LSE, lds);
                u = unext;
            }
#undef ATT_UIDX
        }
        GSYNC();
#ifndef REP_CMB
#define REP_CMB 1
#endif
        for (int rc_ = 0; rc_ < REP_CMB; ++rc_) { int t_ = threadIdx.x; asm volatile("" : "+v"(t_)); att_combine(ws, LSE, MIX, bx * (NWAVES * 64) + t_, G * NWAVES * 64); }
        GSYNC();
        for (int rnd = 0; rnd < 2; ++rnd) {
            pg8::Gemm g{MIX, (const bf16*)(ws + WS_WOUT) + (size_t)l * DM * DM, M, DM, DM}; OneUnit S; S.base.init(M, DM, G, bx); S.round = rnd;
            unsigned* cb = barw + FX_CNT_WORD + ((l * 2 + 0) * 2) * 128 * 64;
            EpiRmsRes E{(l == 0) ? (const void*)x_in : (const void*)XR, (void*)XR, args.in[2] + l * DM, RS2, RowStats{(float*)(ws + WS_FX1), cb}, RowStats{(float*)(ws + WS_FX2), cb + 128 * 64}, (l == 0) ? 1 : 0, 0, (const float*)RS0, (const float*)RS0};
            pg8::gemm_phase<EpiRmsRes, OneUnit, false, PG8_SP2>(lds, g, S, E);
        }
        GSYNC();
#ifndef REP_G3
#define REP_G3 1
#endif
        for (int rep_ = 0; rep_ < REP_G3; ++rep_) {
            pg8::Gemm g{XR, (const bf16*)(ws + WS_WFF1) + (size_t)l * DFF * DM, M, DFF, DM}; pg8::StaticOrder S; S.init(M, DFF, G, bx);
            pg8::EpiBf16<2> E{AB, DFF, nullptr, 0, 0, 1.f, nullptr, lds + XEPI_LDS_OFF, 1};
            pg8::gemm_phase<pg8::EpiBf16<2>, pg8::StaticOrder, PG8_ALIGN, PG8_SP2>(lds, g, S, E);
        }
        GSYNC();
        for (int rnd = 0; rnd < 2; ++rnd) {
            pg8::Gemm g{AB, (const bf16*)(ws + WS_WFF2) + (size_t)l * DM * DFF, M, DM, DFF}; OneUnit S; S.base.init(M, DM, G, bx); S.round = rnd;
            unsigned* cb = barw + FX_CNT_WORD + ((l * 2 + 1) * 2) * 128 * 64;
            const int lastl = (l + 1 == DEPTH) ? 1 : 0;
            EpiRmsRes E{(const void*)XR, lastl ? (void*)xres : (void*)XR, args.in[4] + l * DM, RS1, RowStats{(float*)(ws + WS_FX1), cb}, RowStats{(float*)(ws + WS_FX2), cb + 128 * 64}, 0, lastl, (const float*)RS2, (const float*)RS0};
            pg8::gemm_phase<EpiRmsRes, OneUnit, false, PG8_SP2, true>(lds, g, S, E);
        }
        if (l + 1 < DEPTH) GSYNC();
    }
}

extern "C" void kernel_launch(void* const* d_in, const int* in_sizes, int n_in, void* d_out, int out_size, void* d_ws, size_t ws_size, hipStream_t stream) {
    static int grid = 0;
    if (grid == 0) {
        if (n_in != 16 || in_sizes[0] != M * DM || out_size != M * DM || ws_size < WS_END) { fprintf(stderr, "kernel_launch: unexpected shapes (n_in %d, in0 %d, out %d, ws %zu); nothing launched\n", n_in, n_in > 0 ? in_sizes[0] : -1, out_size, ws_size); grid = -1; return; }
        int dev = 0, cus = 0, per_cu = 0;
        if (hipGetDevice(&dev) != hipSuccess || hipDeviceGetAttribute(&cus, hipDeviceAttributeMultiprocessorCount, dev) != hipSuccess) { grid = -1; return; }
        if (hipFuncSetAttribute((const void*)mega_fwd, hipFuncAttributeMaxDynamicSharedMemorySize, LDS_BYTES) != hipSuccess) { fprintf(stderr, "kernel_launch: hipFuncSetAttribute failed\n"); grid = -1; return; }
        if (hipOccupancyMaxActiveBlocksPerMultiprocessor(&per_cu, (const void*)mega_fwd, NWAVES * 64, LDS_BYTES) != hipSuccess || per_cu < 1) { fprintf(stderr, "kernel_launch: occupancy query says %d\n", per_cu); per_cu = 1; }
        (void)hipGetLastError();
        grid = cus * per_cu;
    }
    if (grid < 0) return;
    Args a{};
    for (int i = 0; i < 16; ++i) a.in[i] = (const float*)d_in[i];
    a.out = (float*)d_out; a.ws = (unsigned char*)d_ws;
    void* kargs[] = {&a};
    hipError_t e = hipLaunchCooperativeKernel((const void*)mega_fwd, dim3(grid), dim3(NWAVES * 64), kargs, LDS_BYTES, stream);
    if (e != hipSuccess) fprintf(stderr, "kernel_launch: cooperative launch failed: %s (grid %d)\n", hipGetErrorString(e), grid);
}
```

```cpp
#include <hip/hip_runtime.h>
#include <hip/hip_cooperative_groups.h>
#include <cstdio>
#include <cstdint>
namespace cg = cooperative_groups;
#ifndef PG8_BTILED
#define PG8_BTILED true
#endif
namespace pg8 {
#define PG8_LAS __attribute__((address_space(3)))
typedef unsigned short bf16_t;
typedef short bf16x8 __attribute__((ext_vector_type(8)));
typedef float f32x4 __attribute__((ext_vector_type(4)));
typedef unsigned u32x4 __attribute__((ext_vector_type(4)));
constexpr int BM = 256, BK = 64, HALF = 128, HTB = HALF * BK * 2  , STAGE_BYTES = 8 * HTB, NXCD = 8, WGM = 8;

__host__ __device__ __forceinline__ int lds_byte(int r, int c) { const int st = (r >> 4) * 2 + (c >> 5), rr = r & 15, cc = c & 31, ob = rr * 64 + cc * 2; return st * 1024 + (ob ^ (((ob >> 9) & 1) << 5)); }
__host__ __device__ __forceinline__ void stage_rc(int b, int& R, int& C) { const int st = b / 1024, sb = b % 1024, swz = sb ^ (((sb >> 9) & 1) << 5); R = (st >> 1) * 16 + swz / 64; C = (st & 1) * 32 + (swz % 64) / 2; }
__host__ __device__ __forceinline__ int perm32(int rho) { const int n = rho >> 4, i = rho & 15; return 8 * (i >> 2) + 4 * n + (i & 3); }

struct Unit { int pm, pn; };
struct Gemm { const bf16_t* A; const bf16_t* Bt; int M, N, K; };

struct StaticOrder {
    int nM, nN, nwg, G, c;
    __host__ __device__ void init(int M, int N, int G_, int c_) { nM = M / BM; nN = N / BM; nwg = nM * nN; G = G_; c = c_; }
    __host__ __device__ bool next(int i, Unit& u) const {
        const long L = (long)i * G + c; if (L >= nwg) return false;
        int wgid = (int)L; { const int q = nwg / NXCD, r = nwg % NXCD, xcd = wgid % NXCD, off = wgid / NXCD; wgid = (xcd < r ? xcd * (q + 1) : r * (q + 1) + (xcd - r) * q) + off; }
        const int nig = WGM * nN, gid = wgid / nig, fm = gid * WGM, gsz = (nM - fm) < WGM ? (nM - fm) : WGM;
        u.pm = fm + ((wgid % nig) % gsz); u.pn = (wgid % nig) / gsz; return true;
    }
    __device__ __forceinline__ void a_ready(const Unit&) const {}
    __device__ __forceinline__ void done(const Unit&) const {}
};

__device__ __forceinline__ unsigned cvt_pk_bf16(float lo, float hi) { unsigned r; asm volatile("v_cvt_pk_bf16_f32 %0, %1, %2" : "=v"(r) : "v"(lo), "v"(hi)); return r; }
typedef float f32x2 __attribute__((ext_vector_type(2)));
__device__ __forceinline__ f32x2 gelu_pk(f32x2 v) {
    const f32x2 av = __builtin_elementwise_abs(v), d = av * 0.2316418882f + 1.0f;
    f32x2 t; t.x = __builtin_amdgcn_rcpf(d.x); t.y = __builtin_amdgcn_rcpf(d.y);
    f32x2 q = t * 0.5307027145f + (-0.7265760135f); q = q * t + 0.7107068705f; q = q * t + (-0.142248368f); q = q * t + 0.127414796f; q = q * t;
    const f32x2 s = (v * v) * (-0.72134752044f);
    f32x2 e; e.x = __builtin_amdgcn_exp2f(s.x); e.y = __builtin_amdgcn_exp2f(s.y);
    const f32x2 m = v * (q * e), r = v - m;
    f32x2 o; o.x = v.x < 0.f ? m.x : r.x; o.y = v.y < 0.f ? m.y : r.y; return o;
}

template <int ACT  > struct EpiBf16 {
    static constexpr bool PERM = true, AFTER_DRAIN = false; static_assert(ACT == 0 || ACT == 1 || ACT == 2, "EpiBf16: ACT is 0 (none), 1 (gelu_pk) or 2 (squared relu)");
    bf16_t* O; int ldc; const float* bias; int split_cols; size_t split_stride; float scale0; const float* rowscale; PG8_LAS unsigned char* xlds; int tiled;
    __device__ __forceinline__ void operator()(const f32x4 (&acc)[2][2][4][2], const Unit& u, int wr, int wc, int fr, int fq) const {
        const int row0 = u.pm * BM + wr * 64 + fr; int colt = u.pn * BM; bf16_t* base = O;
        float sc = 1.f; if (split_cols) { const int t = colt / split_cols; base += (size_t)t * split_stride; colt -= t * split_cols; if (t == 0) sc = scale0; }
        const int col0 = colt + wc * 64 + 8 * fq, bcol0 = u.pn * BM + wc * 64 + 8 * fq;
        const int lane_ = fq * 16 + fr; PG8_LAS unsigned char* xw = xlds ? xlds + (wr * 4 + wc) * 2048 : xlds;
        float rs8[8];
#pragma unroll
        for (int i = 0; i < 8; ++i) rs8[i] = rowscale ? rowscale[row0 + (i >> 2) * HALF + (i & 3) * 16] : 1.f;
        f32x4 bv[2][2];
#pragma unroll
        for (int bj = 0; bj < 2; ++bj)
#pragma unroll
            for (int n = 0; n < 2; ++n) bv[bj][n] = bias ? *(const f32x4*)(bias + bcol0 + bj * 32 + 4 * n) : (f32x4){0.f, 0.f, 0.f, 0.f};
#pragma unroll
        for (int ai = 0; ai < 2; ++ai)
#pragma unroll
            for (int m = 0; m < 4; ++m) { bf16_t* rowp = base + (size_t)(row0 + ai * HALF + m * 16) * ldc + col0; const float rsv = rs8[ai * 4 + m];
#pragma unroll
                for (int bj = 0; bj < 2; ++bj) { f32x4 v0 = (acc[ai][bj][m][0] + bv[bj][0]) * rsv, v1 = (acc[ai][bj][m][1] + bv[bj][1]) * rsv;
                    if (ACT == 1) { f32x2 a = gelu_pk((f32x2){v0[0], v0[1]}), b = gelu_pk((f32x2){v0[2], v0[3]}), c = gelu_pk((f32x2){v1[0], v1[1]}), d = gelu_pk((f32x2){v1[2], v1[3]});
                        v0 = (f32x4){a.x, a.y, b.x, b.y}; v1 = (f32x4){c.x, c.y, d.x, d.y}; }
                    if (ACT == 2) { _Pragma("unroll") for (int e = 0; e < 4; ++e) { const float p0 = __builtin_fmaxf(v0[e], 0.f), p1 = __builtin_fmaxf(v1[e], 0.f); v0[e] = p0 * p0; v1[e] = p1 * p1; } }
                    v0 = v0 * sc; v1 = v1 * sc; u32x4 w; w.x = cvt_pk_bf16(v0[0], v0[1]); w.y = cvt_pk_bf16(v0[2], v0[3]); w.z = cvt_pk_bf16(v1[0], v1[1]); w.w = cvt_pk_bf16(v1[2], v1[3]);
                    if (tiled) *(u32x4*)(base + ((size_t)((u.pm * BM + wr * 64 + ai * HALF + m * 16) >> 4) * (ldc >> 5) + ((colt + wc * 64 + bj * 32) >> 5)) * 512 + fr * 32 + 8 * fq) = w;
                    else if (xlds) *(PG8_LAS u32x4*)(xw + fr * 128 + (((bj * 4 + fq) ^ (fr & 7)) << 4)) = w;
                    else *(u32x4*)(rowp + bj * 32) = w; }
                if (xlds && !tiled) { asm volatile("s_waitcnt lgkmcnt(0)" ::: "memory");
                    bf16_t* gp = base + (size_t)(u.pm * BM + wr * 64 + ai * HALF + m * 16) * ldc + colt + wc * 64;
#pragma unroll
                    for (int hh = 0; hh < 2; ++hh) { const int rr = (lane_ >> 3) + 8 * hh, ch = lane_ & 7;
                        const u32x4 t = *(const PG8_LAS u32x4*)(xw + rr * 128 + ((ch ^ (rr & 7)) << 4));
                        *(u32x4*)(gp + (size_t)rr * ldc + ch * 8) = t; }
                    asm volatile("s_waitcnt lgkmcnt(0)" ::: "memory"); } }
    }
};
template <class Epi, class Sched, bool ALIGN_EPI = false, bool SP2 = false, bool ATILED = false>
__device__ __forceinline__ void gemm_phase(PG8_LAS unsigned char* lds, const Gemm g, const Sched& S, const Epi& E) {
    int tid_ = threadIdx.x; asm volatile("" : "+v"(tid_));
    const int tid = tid_, wid = __builtin_amdgcn_readfirstlane(tid >> 6), lane = tid & 63, wr = wid >> 2, wc = wid & 3, fr = lane & 15, fq = lane >> 4;
    const int K = g.K, nt = K / BK;
    unsigned voffA[2], voffB[2];
#pragma unroll
    for (int i = 0; i < 2; ++i) { int R, C; stage_rc(tid * 16 + i * 8192, R, C); const int Rb = Epi::PERM ? (64 * (R >> 5) + perm32(R & 31)) : R;
        voffA[i] = ATILED ? (unsigned)(((R >> 4) * (K >> 5) + (C >> 5)) * 1024 + (R & 15) * 64 + (C & 31) * 2) : (unsigned)(R * K + C) * 2u; const int Sg = 64 * (R >> 5) + (R & 31);
        voffB[i] = (PG8_BTILED && Epi::PERM) ? (unsigned)(((Sg >> 4) * (K >> 5) + (C >> 5)) * 1024 + (Sg & 15) * 64 + (C & 31) * 2) : (unsigned)(Rb * K + C) * 2u; }
    const size_t kstep = (size_t)(BK * 2);
    const size_t kstepB = (PG8_BTILED && Epi::PERM) ? (size_t)2048 : kstep;
    const size_t kstepA = ATILED ? (size_t)2048 : kstep;
    const size_t hstep = (size_t)HALF * K * 2;
    const size_t hstepB = Epi::PERM ? (size_t)32 * K * 2 : hstep;
    const size_t tstep = 2 * hstep;
    const unsigned ldsw = (unsigned)wid * 1024u;
    const int aoff = lds_byte(wr * 64 + fr, fq * 8), boff = lds_byte(wc * 32 + fr, fq * 8);
#define PG8_SA(b, h) (((b) * 2 + (h)) * HTB)
#define PG8_SB(b, h) ((4 + (b) * 2 + (h)) * HTB)
#define PG8_STAGE(bufoff, gbase, voff) do { _Pragma("unroll") for (int _i = 0; _i < 2; ++_i) \
        __builtin_amdgcn_global_load_lds((const unsigned*)((const char*)(gbase) + (voff)[_i]), (PG8_LAS unsigned*)(lds + (bufoff) + ldsw + _i * 8192), 16, 0, 0); } while (0)
#define PG8_LDA(dst, b, h) do { _Pragma("unroll") for (int m = 0; m < 4; ++m) _Pragma("unroll") for (int k = 0; k < 2; ++k) dst[m][k] = *(const PG8_LAS bf16x8*)(lds + PG8_SA(b, h) + aoff + m * 2048 + k * 1024); } while (0)
#define PG8_LDB(dst, b, h) do { _Pragma("unroll") for (int n = 0; n < 2; ++n) _Pragma("unroll") for (int k = 0; k < 2; ++k) dst[n][k] = *(const PG8_LAS bf16x8*)(lds + PG8_SB(b, h) + boff + n * 2048 + k * 1024); } while (0)
#define PG8_MMA(ai, bj, At, Bt) do { __builtin_amdgcn_s_setprio(1); _Pragma("unroll") for (int m = 0; m < 4; ++m) _Pragma("unroll") for (int n = 0; n < 2; ++n) _Pragma("unroll") for (int k = 0; k < 2; ++k) \
        acc[ai][bj][m][n] = __builtin_amdgcn_mfma_f32_16x16x32_bf16(Bt[n][k], At[m][k], acc[ai][bj][m][n], 0, 0, 0); __builtin_amdgcn_s_setprio(0); } while (0)
#define PG8_WAIT_V(n) asm volatile("s_waitcnt vmcnt(" #n ")" ::: "memory")
#define PG8_WAIT_L(n) asm volatile("s_waitcnt lgkmcnt(" #n ")" ::: "memory")
#define PG8_BAR __builtin_amdgcn_s_barrier()
#define PG8_SCHED __builtin_amdgcn_sched_barrier(0)
    Unit cur, nxt; int ui = 0;
    if (!S.next(0, cur)) return;
    f32x4 acc[2][2][4][2];
#pragma unroll
    for (int a = 0; a < 2; ++a)
#pragma unroll
        for (int b = 0; b < 2; ++b)
#pragma unroll
            for (int m = 0; m < 4; ++m)
#pragma unroll
                for (int n = 0; n < 2; ++n) acc[a][b][m][n] = (f32x4){0.f, 0.f, 0.f, 0.f};
    bf16x8 At[4][2], B0[2][2], B1[2][2];
    const char* cA = (const char*)g.A + (size_t)cur.pm * tstep; const char* cB = (const char*)g.Bt + (size_t)cur.pn * tstep;
    S.a_ready(cur);
    if constexpr (SP2) {
        PG8_STAGE(PG8_SB(0, 0), cB, voffB); PG8_STAGE(PG8_SB(0, 1), cB + hstepB, voffB); PG8_STAGE(PG8_SA(0, 0), cA, voffA); PG8_STAGE(PG8_SA(0, 1), cA + hstep, voffA);
        if (wr == 1) PG8_BAR;
        PG8_WAIT_V(2); PG8_BAR;
        PG8_STAGE(PG8_SB(1, 0), cB + kstepB, voffB); PG8_STAGE(PG8_SA(1, 0), cA + kstepA, voffA); PG8_STAGE(PG8_SB(1, 1), cB + hstepB + kstepB, voffB);
        PG8_WAIT_V(6); PG8_BAR;
    } else {
        PG8_STAGE(PG8_SB(0, 0), cB, voffB); PG8_STAGE(PG8_SA(0, 0), cA, voffA); PG8_STAGE(PG8_SB(0, 1), cB + hstepB, voffB); PG8_STAGE(PG8_SA(0, 1), cA + hstep, voffA);
        if (wr == 1) PG8_BAR;
        PG8_WAIT_V(4); PG8_BAR;
        PG8_STAGE(PG8_SB(1, 0), cB + kstepB, voffB); PG8_STAGE(PG8_SA(1, 0), cA + kstepA, voffA); PG8_STAGE(PG8_SB(1, 1), cB + hstepB + kstepB, voffB);
        PG8_WAIT_V(6); PG8_BAR;
    }
    for (;;) {
        const bool has_next = S.next(ui + 1, nxt);
        const char* nA = has_next ? (const char*)g.A + (size_t)nxt.pm * tstep : cA; const char* nB = has_next ? (const char*)g.Bt + (size_t)nxt.pn * tstep : cB;
        for (int t = 0; t < nt; t += 2) {
            const bool last = (t == nt - 2);
            const char* a1 = cA + (size_t)(t + 1) * kstepA;
            const char* a2 = last ? nA : cA + (size_t)(t + 2) * kstepA; const char* b2 = last ? nB : cB + (size_t)(t + 2) * kstepB;
            const char* a3 = a2 + kstepA; const char* b3 = b2 + kstepB;
            if (last && has_next) S.a_ready(nxt);
            if constexpr (SP2) {
            PG8_LDB(B0, 0, 0); PG8_LDB(B1, 0, 1); PG8_SCHED; PG8_LDA(At, 0, 0); PG8_STAGE(PG8_SA(1, 1), a1 + hstep, voffA);
            PG8_WAIT_V(8); PG8_WAIT_L(0); PG8_BAR; PG8_MMA(0, 0, At, B0); PG8_MMA(0, 1, At, B1); PG8_BAR; PG8_SCHED;
            PG8_LDA(At, 0, 1); PG8_STAGE(PG8_SB(0, 0), b2, voffB); PG8_STAGE(PG8_SB(0, 1), b2 + hstepB, voffB); PG8_STAGE(PG8_SA(0, 0), a2, voffA);
            PG8_WAIT_V(8); PG8_WAIT_L(0); PG8_BAR; PG8_MMA(1, 0, At, B0); PG8_MMA(1, 1, At, B1); PG8_BAR; PG8_SCHED;
            PG8_LDB(B0, 1, 0); PG8_LDB(B1, 1, 1); PG8_SCHED; PG8_LDA(At, 1, 0); PG8_STAGE(PG8_SA(0, 1), a2 + hstep, voffA);
            PG8_WAIT_V(8); PG8_WAIT_L(0); PG8_BAR; PG8_MMA(0, 0, At, B0); PG8_MMA(0, 1, At, B1); PG8_BAR; PG8_SCHED;
            PG8_LDA(At, 1, 1); PG8_STAGE(PG8_SB(1, 0), b3, voffB); PG8_STAGE(PG8_SB(1, 1), b3 + hstepB, voffB); PG8_STAGE(PG8_SA(1, 0), a3, voffA);
            PG8_WAIT_V(8); PG8_WAIT_L(0); PG8_BAR; PG8_MMA(1, 0, At, B0); PG8_MMA(1, 1, At, B1); PG8_BAR; PG8_SCHED;
            } else {
            PG8_LDB(B0, 0, 0); PG8_SCHED; PG8_LDA(At, 0, 0); PG8_STAGE(PG8_SA(1, 1), a1 + hstep, voffA);
            PG8_WAIT_L(8); PG8_BAR; PG8_WAIT_L(0); PG8_MMA(0, 0, At, B0); PG8_BAR; PG8_SCHED;
            PG8_LDB(B1, 0, 1); PG8_STAGE(PG8_SB(0, 0), b2, voffB);
            PG8_BAR; PG8_WAIT_L(0); PG8_MMA(0, 1, At, B1); PG8_BAR;
            PG8_LDA(At, 0, 1); PG8_STAGE(PG8_SA(0, 0), a2, voffA);
            PG8_BAR; PG8_WAIT_L(0); PG8_MMA(1, 0, At, B0); PG8_BAR; PG8_SCHED;
            PG8_STAGE(PG8_SB(0, 1), b2 + hstepB, voffB);
            PG8_WAIT_V(6); PG8_BAR; PG8_MMA(1, 1, At, B1); PG8_BAR;
            PG8_LDB(B0, 1, 0); PG8_SCHED; PG8_LDA(At, 1, 0); PG8_STAGE(PG8_SA(0, 1), a2 + hstep, voffA);
            PG8_WAIT_L(8); PG8_BAR; PG8_WAIT_L(0); PG8_MMA(0, 0, At, B0); PG8_BAR; PG8_SCHED;
            PG8_LDB(B1, 1, 1); PG8_STAGE(PG8_SB(1, 0), b3, voffB);
            PG8_BAR; PG8_WAIT_L(0); PG8_MMA(0, 1, At, B1); PG8_BAR;
            PG8_LDA(At, 1, 1); PG8_STAGE(PG8_SA(1, 0), a3, voffA);
            PG8_BAR; PG8_WAIT_L(0); PG8_MMA(1, 0, At, B0); PG8_BAR; PG8_SCHED;
            PG8_STAGE(PG8_SB(1, 1), b3 + hstepB, voffB);
            PG8_WAIT_V(6); PG8_BAR; PG8_MMA(1, 1, At, B1); PG8_BAR;
            }
        }
        if constexpr (ALIGN_EPI) { if (wr == 0) PG8_BAR; }
        if constexpr (!Epi::AFTER_DRAIN) { E(acc, cur, wr, wc, fr, fq); S.done(cur); }
        if (!has_next) break;
#pragma unroll
        for (int a = 0; a < 2; ++a)
#pragma unroll
            for (int b = 0; b < 2; ++b)
#pragma unroll
                for (int m = 0; m < 4; ++m)
#pragma unroll
                    for (int n = 0; n < 2; ++n) acc[a][b][m][n] = (f32x4){0.f, 0.f, 0.f, 0.f};
        cur = nxt; cA = nA; cB = nB; ++ui;
        if constexpr (ALIGN_EPI) { if (wr == 1) PG8_BAR; }
    }
    PG8_WAIT_V(0);
    if constexpr (!ALIGN_EPI) { if (wr == 0) PG8_BAR; }
    PG8_BAR;
    if constexpr (Epi::AFTER_DRAIN) { E.fused(acc, cur, wr, wc, fr, fq, lds, wid, lane); S.done(cur); }
#undef PG8_SA
#undef PG8_SB
#undef PG8_STAGE
#undef PG8_LDA
#undef PG8_LDB
#undef PG8_MMA
#undef PG8_WAIT_V
#undef PG8_WAIT_L
#undef PG8_BAR
#undef PG8_SCHED
}
}

#ifndef PG8_SP2
#define PG8_SP2 true
#endif
#ifndef PG8_ALIGN
#define PG8_ALIGN true
#endif

constexpr int NB = 8, SEQ = 4096, DM = 1024, DEPTH = 4, NH = 8, HD = 64, AW = 512, LW = 512, INW = 2560, DFF = 4096;
constexpr int M = NB * SEQ;
constexpr float EPS = 1e-6f;
constexpr float QSCALE = 0.125f * 1.4426950408889634f;

constexpr size_t MiB = 1u << 20;
constexpr size_t WS_CTL = 0;
constexpr size_t WS_WIN = 1 * MiB, WS_WOUT = 21 * MiB, WS_WFF1 = 29 * MiB, WS_WFF2 = 61 * MiB;
constexpr size_t WS_H = 96 * MiB;
constexpr size_t WS_XR = 160 * MiB;
constexpr size_t WS_MB = 224 * MiB;
constexpr size_t WS_OP01 = 96 * MiB;
constexpr size_t WS_OP2 = 448 * MiB;
constexpr size_t WS_LSE = 480 * MiB;
constexpr size_t WS_Z = 224 * MiB;
constexpr size_t WS_MIX = 384 * MiB;
constexpr size_t WS_A = 224 * MiB;
constexpr size_t WS_RS1 = 484 * MiB;
constexpr size_t WS_RS2 = 484 * MiB + 262144;
constexpr size_t WS_FX1 = 485 * MiB, WS_FX2 = 485 * MiB + 524288;
constexpr size_t WS_END = 486 * MiB;
__device__ __forceinline__ unsigned short* op_base(unsigned char* ws, int p) { return (unsigned short*)(ws + (p == 2 ? WS_OP2 : WS_OP01 + (size_t)p * (32 * MiB))); }

constexpr int LDS_BYTES = 151552;
constexpr int XEPI_LDS_OFF = 133120;
constexpr int NWAVES = 8;

#define LAS __attribute__((address_space(3)))
typedef unsigned short bf16;
typedef short bf16x8 __attribute__((ext_vector_type(8)));
typedef short s16x4 __attribute__((ext_vector_type(4)));
typedef float f32x4 __attribute__((ext_vector_type(4)));
typedef unsigned u32x4 __attribute__((ext_vector_type(4)));
typedef unsigned u32x2 __attribute__((ext_vector_type(2)));

__device__ __forceinline__ unsigned f2bf(float f) { unsigned u = __builtin_bit_cast(unsigned, f); return (u + 0x7fffu + ((u >> 16) & 1u)) >> 16; }
typedef float f32x2_t __attribute__((ext_vector_type(2))); typedef __bf16 bf16x2_t __attribute__((ext_vector_type(2)));
__device__ __forceinline__ unsigned pk2(float lo, float hi) { f32x2_t v = {lo, hi}; bf16x2_t b = __builtin_convertvector(v, bf16x2_t); return __builtin_bit_cast(unsigned, b); }
__device__ __forceinline__ float bflo(unsigned w) { return __uint_as_float(w << 16); }
__device__ __forceinline__ float bfhi(unsigned w) { return __uint_as_float(w & 0xffff0000u); }
__device__ __forceinline__ float wave_sum(float v) {
#pragma unroll
    for (int o = 1; o < 64; o <<= 1) v += __shfl_xor(v, o);
    return v;
}

__device__ __forceinline__ void p0_transpose_item(const float* W, int K, int N, bf16* WT, LAS float* scr, int item, int lane, const float* gk) {
    const int nblk = N / 32, kb = item / nblk, nb = item % nblk, k0 = 64 * kb, n0 = 32 * nb;
    const int kl = lane >> 3, c4 = lane & 7;
    f32x4 v[8];
#pragma unroll
    for (int i = 0; i < 8; ++i) v[i] = *(const f32x4*)(W + (size_t)(k0 + 8 * i + kl) * N + n0 + 4 * c4);
#pragma unroll
    for (int i = 0; i < 8; ++i) { const float gv = gk ? gk[k0 + 8 * i + kl] : 1.f; LAS float* d = scr + (8 * i + kl) * 33 + 4 * c4; d[0] = v[i].x * gv; d[1] = v[i].y * gv; d[2] = v[i].z * gv; d[3] = v[i].w * gv; }
    asm volatile("s_waitcnt lgkmcnt(0)" ::: "memory");
    const int c = lane & 7;
#pragma unroll
    for (int j = 0; j < 4; ++j) { const int n = (lane >> 3) + 8 * j; const LAS float* s = scr + (8 * c) * 33 + n;
        u32x4 o; o.x = pk2(s[0 * 33], s[1 * 33]); o.y = pk2(s[2 * 33], s[3 * 33]); o.z = pk2(s[4 * 33], s[5 * 33]); o.w = pk2(s[6 * 33], s[7 * 33]);
        if (PG8_BTILED) { const int n_ = n0 + n, sg = 32 * (n_ >> 5) + 16 * ((n_ >> 2) & 1) + ((((n_ & 31) >> 3) << 2) | (n_ & 3)), kk = k0 + 8 * c;
            *(u32x4*)(WT + ((size_t)(sg >> 4) * (K >> 5) + (kk >> 5)) * 512 + (sg & 15) * 32 + (kk & 31)) = o; }
        else *(u32x4*)(WT + (size_t)(n0 + n) * K + k0 + 8 * c) = o; }
    asm volatile("s_waitcnt lgkmcnt(0)" ::: "memory");
}

template <int R> __device__ __forceinline__ void rms_rows_to_bf16(const float* x, float* rsout, bf16* out, int m0, int mstride, int lane) {
    f32x4 v[R][4]; float s[R];
#pragma unroll
    for (int r = 0; r < R; ++r)
#pragma unroll
        for (int j = 0; j < 4; ++j) v[r][j] = *((const f32x4*)(x + (size_t)(m0 + r * mstride) * DM) + lane + 64 * j);
#pragma unroll
    for (int r = 0; r < R; ++r) { float a = 0.f;
#pragma unroll
        for (int j = 0; j < 4; ++j) a += (v[r][j].x * v[r][j].x + v[r][j].y * v[r][j].y) + (v[r][j].z * v[r][j].z + v[r][j].w * v[r][j].w);
        s[r] = a; }
#pragma unroll
    for (int o = 1; o < 64; o <<= 1)
#pragma unroll
        for (int r = 0; r < R; ++r) s[r] += __shfl_xor(s[r], o);
#pragma unroll
    for (int r = 0; r < R; ++r) { if (lane == 0) rsout[m0 + r * mstride] = __builtin_amdgcn_rsqf(s[r] * (1.f / DM) + EPS);
        u32x2* o8 = (u32x2*)(out + (size_t)(m0 + r * mstride) * DM) + lane;
#pragma unroll
        for (int j = 0; j < 4; ++j) { u32x2 w; w.x = pk2(v[r][j].x, v[r][j].y); w.y = pk2(v[r][j].z, v[r][j].w); o8[64 * j] = w; } }
}

template <int R, bool XIN32, bool XOUT32> __device__ __forceinline__ void post_norm_rows(const bf16* mb, const void* xin, void* xout, const float* gpost, float* rsout, int m0, int mstride, int lane) {
    f32x4 xv[R][4]; u32x2 mw[R][4]; float s[R];
#pragma unroll
    for (int r = 0; r < R; ++r)
#pragma unroll
        for (int j = 0; j < 4; ++j) { const size_t ro = (size_t)(m0 + r * mstride) * DM; mw[r][j] = *((const u32x2*)(mb + ro) + lane + 64 * j);
            if (XIN32) xv[r][j] = *((const f32x4*)((const float*)xin + ro) + lane + 64 * j);
            else { const u32x2 w = *((const u32x2*)((const bf16*)xin + ro) + lane + 64 * j); xv[r][j] = (f32x4){bflo(w.x), bfhi(w.x), bflo(w.y), bfhi(w.y)}; } }
    f32x4 gg[4];
#pragma unroll
    for (int j = 0; j < 4; ++j) gg[j] = *((const f32x4*)gpost + lane + 64 * j);
#pragma unroll
    for (int r = 0; r < R; ++r) { float a = 0.f;
#pragma unroll
        for (int j = 0; j < 4; ++j) { const float a0 = bflo(mw[r][j].x), a1 = bfhi(mw[r][j].x), a2 = bflo(mw[r][j].y), a3 = bfhi(mw[r][j].y); a += (a0 * a0 + a1 * a1) + (a2 * a2 + a3 * a3); }
        s[r] = a; }
#pragma unroll
    for (int o = 1; o < 64; o <<= 1)
#pragma unroll
        for (int r = 0; r < R; ++r) s[r] += __shfl_xor(s[r], o);
#pragma unroll
    for (int r = 0; r < R; ++r) { const float rs = __builtin_amdgcn_rsqf(s[r] * (1.f / DM) + EPS); float a = 0.f; const size_t ro = (size_t)(m0 + r * mstride) * DM;
#pragma unroll
        for (int j = 0; j < 4; ++j) { const f32x4 mv = {bflo(mw[r][j].x), bfhi(mw[r][j].x), bflo(mw[r][j].y), bfhi(mw[r][j].y)};
            xv[r][j] = xv[r][j] + mv * rs * gg[j];
            if (XOUT32) *((f32x4*)((float*)xout + ro) + lane + 64 * j) = xv[r][j];
            else { u32x2 w; w.x = pk2(xv[r][j].x, xv[r][j].y); w.y = pk2(xv[r][j].z, xv[r][j].w); *((u32x2*)((bf16*)xout + ro) + lane + 64 * j) = w; }
            a += (xv[r][j].x * xv[r][j].x + xv[r][j].y * xv[r][j].y) + (xv[r][j].z * xv[r][j].z + xv[r][j].w * xv[r][j].w); }
        s[r] = a; }
    if (rsout) {
#pragma unroll
        for (int o = 1; o < 64; o <<= 1)
#pragma unroll
            for (int r = 0; r < R; ++r) s[r] += __shfl_xor(s[r], o);
#pragma unroll
        for (int r = 0; r < R; ++r) if (lane == 0) rsout[m0 + r * mstride] = __builtin_amdgcn_rsqf(s[r] * (1.f / DM) + EPS);
    }
}

constexpr int LRU_LDS_OFF = 98304;
constexpr int XB_LDS_OFF = 132096;
__device__ __forceinline__ float sigmoidf_(float x) { return __builtin_amdgcn_rcpf(1.0f + __builtin_amdgcn_exp2f(-1.4426950408889634f * x)); }
__device__ __forceinline__ float gelu_tanh(float g) { const float y2 = (2.0f * 0.7978845608028654f) * (g + 0.044715f * g * g * g); return g * sigmoidf_(y2); }

__device__ __forceinline__ void lru_unit(int unit, const bf16* Z, bf16* MIX, const float* conv_w, const float* conv_b, const float* w_r, const float* b_r,
                                         const float* w_i, const float* b_i, const float* lam, LAS unsigned char* lds) {
    const int qt = unit & 3, n = (unit >> 2) & 7, b = unit >> 5;
    int tid_ = threadIdx.x; asm volatile("" : "+v"(tid_));
    const int tid = tid_, lane = tid & 63, wid = __builtin_amdgcn_readfirstlane(tid >> 6), l15 = lane & 15, fq = lane >> 4;
    bf16x8 wd[4][2]; f32x4 cbv[4];
    bf16x8 wr[2], wi[2], wx[2];
#pragma unroll
    for (int ct = 0; ct < 4; ++ct) {
#pragma unroll
        for (int r = 0; r < 4; ++r) cbv[ct][r] = conv_b[64 * n + 16 * ct + 4 * fq + r];
#pragma unroll
        for (int ksp = 0; ksp < 2; ++ksp)
#pragma unroll
            for (int j = 0; j < 8; ++j) { const int tap = 2 * ksp + (fq >> 1), chl = 8 * (fq & 1) + j;
                wd[ct][ksp][j] = (chl == l15) ? (short)f2bf(conv_w[tap * LW + 64 * n + 16 * ct + chl]) : (short)0; }
    }
#pragma unroll
    for (int ks = 0; ks < 2; ++ks)
#pragma unroll
        for (int j = 0; j < 8; ++j) { const int sig = 16 * (2 * ks + (j >> 2)) + 4 * fq + (j & 3);
            wr[ks][j] = (short)f2bf(w_r[(size_t)(n * 64 + sig) * 64 + 16 * qt + l15]);
            wi[ks][j] = (short)f2bf(w_i[(size_t)(n * 64 + sig) * 64 + 16 * qt + l15]);
            wx[ks][j] = (sig == 16 * qt + l15) ? (short)0x3F80 : (short)0; }
    const int chan = 64 * n + 16 * qt + l15;
    const float br = b_r[chan], bi = b_i[chan], sp8 = -8.0f * log1pf(__expf(-lam[chan]));
    const bf16* Zb = Z + (size_t)b * SEQ * INW;
    bf16* Ob = MIX + (size_t)b * SEQ * DM + AW + chan;
    float hseg = 0.f;
    constexpr int XRP = 144;
    LAS unsigned char* xrw = lds + wid * (72 * XRP);
    const int lr8 = lane >> 3, lc8 = lane & 7;
    const bf16* Zx = Zb + 1536 + 64 * n + 8 * lc8;
    u32x4 nx[9];
#define LRU_ROWS(tbase) do { _Pragma("unroll") for (int g_ = 0; g_ < 9; ++g_) { int tr_ = (tbase) - 8 + 8 * g_ + lr8; tr_ = tr_ < 0 ? 0 : (tr_ > SEQ - 1 ? SEQ - 1 : tr_); nx[g_] = *(const u32x4*)(Zx + (size_t)tr_ * INW); } } while (0)
    LRU_ROWS(wid * 64);
    unsigned short grn[4][4];
#pragma unroll
    for (int mt = 0; mt < 4; ++mt)
#pragma unroll
        for (int r = 0; r < 4; ++r) grn[mt][r] = Zb[(size_t)(wid * 64 + 16 * mt + 4 * fq + r) * INW + 2048 + chan];
    for (int seg = 0; seg < 8; ++seg) {
        const int tw = seg * 512 + wid * 64;
        float Cel[4][4], Hel[4][4];
        unsigned short grv[4][4];
#pragma unroll
        for (int mt = 0; mt < 4; ++mt)
#pragma unroll
            for (int r = 0; r < 4; ++r) { grv[mt][r] = grn[mt][r]; const int tn = tw + 512 + 16 * mt + 4 * fq + r; grn[mt][r] = Zb[(size_t)(tn > SEQ - 1 ? SEQ - 1 : tn) * INW + 2048 + chan]; }
#pragma unroll
        for (int g = 0; g < 9; ++g) { u32x4 v = nx[g]; if (g == 0) { if (tw == 0) v = (u32x4){0u, 0u, 0u, 0u}; }
            *(LAS u32x4*)(xrw + (8 * g + lr8) * XRP + lc8 * 16) = v; }
        LRU_ROWS(tw + 512);
        float Cw = 1.f, Hw = 0.f;
#pragma unroll
        for (int mt = 0; mt < 4; ++mt) {
            const int t = tw + 16 * mt + l15;
            f32x4 accr = {0.f, 0.f, 0.f, 0.f}, acci = {0.f, 0.f, 0.f, 0.f}, accx = {0.f, 0.f, 0.f, 0.f};
            f32x4 cacc[4];
#pragma unroll
            for (int ct = 0; ct < 4; ++ct) {
                cacc[ct] = cbv[ct];
#pragma unroll
                for (int ksp = 0; ksp < 2; ++ksp) {
                    const u32x4 v = *(const LAS u32x4*)(xrw + (5 + 16 * mt + l15 + 2 * ksp + (fq >> 1)) * XRP + (16 * ct + 8 * (fq & 1)) * 2);
                    cacc[ct] = __builtin_amdgcn_mfma_f32_16x16x32_bf16(wd[ct][ksp], __builtin_bit_cast(bf16x8, v), cacc[ct], 0, 0, 0);
                }
            }
#pragma unroll
            for (int ks = 0; ks < 2; ++ks) {
                u32x4 ap; ap.x = pk2(cacc[2 * ks][0], cacc[2 * ks][1]); ap.y = pk2(cacc[2 * ks][2], cacc[2 * ks][3]);
                ap.z = pk2(cacc[2 * ks + 1][0], cacc[2 * ks + 1][1]); ap.w = pk2(cacc[2 * ks + 1][2], cacc[2 * ks + 1][3]);
                const bf16x8 a = __builtin_bit_cast(bf16x8, ap);
                accr = __builtin_amdgcn_mfma_f32_16x16x32_bf16(a, wr[ks], accr, 0, 0, 0);
                acci = __builtin_amdgcn_mfma_f32_16x16x32_bf16(a, wi[ks], acci, 0, 0, 0);
                accx = __builtin_amdgcn_mfma_f32_16x16x32_bf16(a, wx[ks], accx, 0, 0, 0);
            }
            float C[4], H[4];
#pragma unroll
            for (int r = 0; r < 4; ++r) {
                const float rg = sigmoidf_(accr[r] + br), ig = sigmoidf_(acci[r] + bi);
                const float la = sp8 * rg; const float a_ = __builtin_amdgcn_exp2f(1.4426950408889634f * la); const float mult = __builtin_amdgcn_sqrtf(fmaxf(1.0f - a_ * a_, 0.f));
                const float u_ = mult * ig * accx[r];
                if (r == 0) { C[0] = a_; H[0] = u_; } else { C[r] = a_ * C[r - 1]; H[r] = a_ * H[r - 1] + u_; }
            }
            float Ct = C[3], Ht = H[3];
            { const float Cp = __shfl_up(Ct, 16), Hp = __shfl_up(Ht, 16); if (fq >= 1) { Ht = Ct * Hp + Ht; Ct = Ct * Cp; } }
            { const float Cp = __shfl_up(Ct, 32), Hp = __shfl_up(Ht, 32); if (fq >= 2) { Ht = Ct * Hp + Ht; Ct = Ct * Cp; } }
            float Ce = __shfl_up(Ct, 16), He = __shfl_up(Ht, 16); if (fq == 0) { Ce = 1.f; He = 0.f; }
            const float Ctile = __shfl(Ct, 48 + l15), Htile = __shfl(Ht, 48 + l15);
            const float Cp = Cw * Ce, Hp = Ce * Hw + He;
#pragma unroll
            for (int r = 0; r < 4; ++r) { Cel[mt][r] = Cp * C[r]; Hel[mt][r] = C[r] * Hp + H[r]; }
            Hw = Ctile * Hw + Htile; Cw = Cw * Ctile;
        }
        LAS float* tot = (LAS float*)(lds + LRU_LDS_OFF) + (seg & 1) * 256;
        if (fq == 0) { tot[(wid * 16 + l15) * 2] = Cw; tot[(wid * 16 + l15) * 2 + 1] = Hw; }
        __syncthreads();
        float hin = hseg, hall = hseg;
#pragma unroll
        for (int w2 = 0; w2 < 8; ++w2) { const float c2 = tot[(w2 * 16 + l15) * 2], h2 = tot[(w2 * 16 + l15) * 2 + 1]; hall = c2 * hall + h2; if (w2 < wid) hin = hall; }
#pragma unroll
        for (int mt = 0; mt < 4; ++mt)
#pragma unroll
            for (int r = 0; r < 4; ++r) {
                const float hv = Cel[mt][r] * hin + Hel[mt][r];
                const float g = __uint_as_float((unsigned)grv[mt][r] << 16);
                Ob[(size_t)(tw + 16 * mt + 4 * fq + r) * DM] = (bf16)f2bf(hv * gelu_tanh(g));
            }
        hseg = hall;
    }
#undef LRU_ROWS
    __syncthreads();
}

constexpr int AT_PITCH = 160;
constexpr int AT_K = 0, AT_V = 384 * AT_PITCH;
constexpr int ATT_UNITS = NB * NH * 3 * 16;

struct AttPre { u32x4 k[6], v[6], q[4]; };
__device__ __forceinline__ void att_decode(int u, int& b, int& h, int& br, int& dsh, int& c, int& n2) {
    const int blk = u & 15, t = u >> 4; br = t % 3; const int bh = t / 3; h = bh & 7; b = bh >> 3; dsh = 2 * br; c = blk >> (4 - dsh); n2 = blk & ((16 >> dsh) - 1);
}
__device__ __forceinline__ void att_issue(int u, const bf16* Z, AttPre& P) {
    int b, h, br, dsh, c, n2; att_decode(u, b, h, br, dsh, c, n2);
    int tid_ = threadIdx.x; asm volatile("" : "+v"(tid_));
    const int tid = tid_, lane = tid & 63, wid = tid >> 6, l15 = lane & 15, fq = lane >> 4;
    const bf16* Zb = Z + (size_t)b * SEQ * INW + h * HD;
#pragma unroll
    for (int i = 0; i < 6; ++i) {
        const int id = tid + 512 * i, row = id >> 3, ch = id & 7; int tau = n2 * 256 - 128 + row; tau = tau < 0 ? 0 : tau;
        const bf16* p = Zb + (size_t)((tau << dsh) + c) * INW + ch * 8;
        P.k[i] = *(const u32x4*)(p + AW); P.v[i] = *(const u32x4*)(p + 2 * AW);
    }
#pragma unroll
    for (int blk = 0; blk < 2; ++blk) {
        const int posq = ((n2 * 256 + 128 * blk + 16 * wid + l15) << dsh) + c;
#pragma unroll
        for (int ks = 0; ks < 2; ++ks) P.q[2 * blk + ks] = *(const u32x4*)(Zb + (size_t)posq * INW + 32 * ks + 8 * fq);
    }
}
__device__ __forceinline__ void att_stage(const AttPre& P, LAS unsigned char* lds) {
    int tid_ = threadIdx.x; asm volatile("" : "+v"(tid_)); const int tid = tid_;
#pragma unroll
    for (int i = 0; i < 6; ++i) { const int id = tid + 512 * i, row = id >> 3, ch = id & 7;
        *(LAS u32x4*)(lds + AT_K + row * AT_PITCH + ch * 16) = P.k[i]; *(LAS u32x4*)(lds + AT_V + row * AT_PITCH + ch * 16) = P.v[i]; }
}
__device__ __forceinline__ s16x4 vtr(const LAS unsigned char* p) { return __builtin_bit_cast(s16x4, __builtin_amdgcn_ds_read_tr16_b64_v4i16((LAS s16x4*)p)); }

__device__ __forceinline__ void att_compute(int u, int blk, const u32x4& qf0, const u32x4& qf1, unsigned char* ws, float* LSE, LAS unsigned char* lds) {
    int b, h, br, dsh, c, n2; att_decode(u, b, h, br, dsh, c, n2); const int n = 2 * n2 + blk;
    int tid_ = threadIdx.x; asm volatile("" : "+v"(tid_));
    const int tid = tid_, lane = tid & 63, wid = __builtin_amdgcn_readfirstlane(tid >> 6), l15 = lane & 15, fq = lane >> 4;
    const bf16x8 q0 = __builtin_bit_cast(bf16x8, qf0), q1 = __builtin_bit_cast(bf16x8, qf1);
    f32x4 s[9];
    const LAS unsigned char* kb = lds + AT_K + (128 * blk + 16 * wid + l15) * AT_PITCH + fq * 16;
#pragma unroll
    for (int j = 0; j < 9; ++j) {
        const bf16x8 a0 = *(const LAS bf16x8*)(kb + j * 16 * AT_PITCH), a1 = *(const LAS bf16x8*)(kb + j * 16 * AT_PITCH + 64);
        f32x4 acc = {0.f, 0.f, 0.f, 0.f};
        acc = __builtin_amdgcn_mfma_f32_16x16x32_bf16(a0, q0, acc, 0, 0, 0);
        acc = __builtin_amdgcn_mfma_f32_16x16x32_bf16(a1, q1, acc, 0, 0, 0);
        s[j] = acc;
    }
    const float NEG = -INFINITY;
#pragma unroll
    for (int r = 0; r < 4; ++r) { const int dlt = 4 * fq + r - l15; if (dlt < 0) s[0][r] = NEG; if (dlt > 0) s[8][r] = NEG; }
    if (n == 0) {
#pragma unroll
        for (int j = 0; j < 8; ++j) if (wid + j < 8) s[j] = (f32x4){NEG, NEG, NEG, NEG};
    }
    float m = NEG;
#pragma unroll
    for (int j = 0; j < 9; ++j) m = fmaxf(m, fmaxf(fmaxf(s[j][0], s[j][1]), fmaxf(s[j][2], s[j][3])));
    m = fmaxf(m, __shfl_xor(m, 16)); m = fmaxf(m, __shfl_xor(m, 32));
    float l = 0.f;
#pragma unroll
    for (int j = 0; j < 9; ++j)
#pragma unroll
        for (int r = 0; r < 4; ++r) { const float p = __builtin_amdgcn_exp2f(s[j][r] - m); s[j][r] = p; l += p; }
    l += __shfl_xor(l, 16); l += __shfl_xor(l, 32);
    bf16x8 pb[5];
#pragma unroll
    for (int pr = 0; pr < 5; ++pr) {
        u32x4 w; w.x = pk2(s[2 * pr][0], s[2 * pr][1]); w.y = pk2(s[2 * pr][2], s[2 * pr][3]);
        if (pr < 4) { w.z = pk2(s[2 * pr + 1][0], s[2 * pr + 1][1]); w.w = pk2(s[2 * pr + 1][2], s[2 * pr + 1][3]); } else { w.z = 0u; w.w = 0u; }
        pb[pr] = __builtin_bit_cast(bf16x8, w);
    }
    const LAS unsigned char* vb = lds + AT_V + (128 * blk + 16 * wid + 4 * fq + (l15 >> 2)) * AT_PITCH + (l15 & 3) * 8;
    f32x4 o[4];
#pragma unroll
    for (int dt = 0; dt < 4; ++dt) {
        f32x4 acc = {0.f, 0.f, 0.f, 0.f};
#pragma unroll
        for (int pr = 0; pr < 5; ++pr) {
            const s16x4 lo = vtr(vb + (2 * pr) * 16 * AT_PITCH + dt * 32);
            s16x4 hi = {0, 0, 0, 0};
            if (pr < 4) hi = vtr(vb + (2 * pr + 1) * 16 * AT_PITCH + dt * 32);
            const bf16x8 a = {lo[0], lo[1], lo[2], lo[3], hi[0], hi[1], hi[2], hi[3]};
            acc = __builtin_amdgcn_mfma_f32_16x16x32_bf16(a, pb[pr], acc, 0, 0, 0);
        }
        o[dt] = acc;
    }
    const float inv = __builtin_amdgcn_rcpf(l);
    const int posq = ((n * 128 + 16 * wid + l15) << dsh) + c;
    const size_t row = (size_t)b * SEQ + posq;
    bf16* op = op_base(ws, br) + row * AW + h * HD + 4 * fq;
#pragma unroll
    for (int dt = 0; dt < 4; ++dt) { u32x2 w; w.x = pk2(o[dt][0] * inv, o[dt][1] * inv); w.y = pk2(o[dt][2] * inv, o[dt][3] * inv); *(u32x2*)(op + 16 * dt) = w; }
    if (fq == 0) LSE[((size_t)br * M + row) * NH + h] = m + __builtin_amdgcn_logf(l);
}

__device__ __forceinline__ void att_combine(unsigned char* ws, const float* LSE, bf16* MIX, int gtid, int gthreads) {
    for (int id = gtid; id < M * 64; id += gthreads) {
        const int row = id >> 6, ch = id & 63, h = ch >> 3;
        float L[3];
#pragma unroll
        for (int p = 0; p < 3; ++p) L[p] = LSE[((size_t)p * M + row) * NH + h];
        const float mx = fmaxf(L[0], fmaxf(L[1], L[2]));
        float w[3]; float sw = 0.f;
#pragma unroll
        for (int p = 0; p < 3; ++p) { w[p] = __builtin_amdgcn_exp2f(L[p] - mx); sw += w[p]; }
        const float isw = __builtin_amdgcn_rcpf(sw);
        float acc[8] = {0.f, 0.f, 0.f, 0.f, 0.f, 0.f, 0.f, 0.f};
#pragma unroll
        for (int p = 0; p < 3; ++p) { const u32x4 v = *(const u32x4*)(op_base(ws, p) + (size_t)row * AW + ch * 8); const float ww = w[p] * isw;
            acc[0] += ww * bflo(v.x); acc[1] += ww * bfhi(v.x); acc[2] += ww * bflo(v.y); acc[3] += ww * bfhi(v.y);
            acc[4] += ww * bflo(v.z); acc[5] += ww * bfhi(v.z); acc[6] += ww * bflo(v.w); acc[7] += ww * bfhi(v.w); }
        u32x4 o; o.x = pk2(acc[0], acc[1]); o.y = pk2(acc[2], acc[3]); o.z = pk2(acc[4], acc[5]); o.w = pk2(acc[6], acc[7]);
        *(u32x4*)(MIX + (size_t)row * DM + ch * 8) = o;
    }
}

#define XB_TMO      128
#define XB_XCNT(j)  (256  + 64 * (j))
#define XB_XSUB(j)  (1280 + 64 * (j))
#define XB_XGEN(j)  (2304 + 64 * (j))
#define XB_TOP      3328
#define XB_TOPGEN   3392
#define XCD_BAR_WORDS 3456
#define XB_SPIN_CAP (1u << 18)

__device__ __forceinline__ unsigned xb_ld(unsigned* p)              { return __hip_atomic_load(p, __ATOMIC_RELAXED, __HIP_MEMORY_SCOPE_AGENT); }
__device__ __forceinline__ unsigned xb_add(unsigned* p, unsigned v) { return __hip_atomic_fetch_add(p, v, __ATOMIC_RELAXED, __HIP_MEMORY_SCOPE_AGENT); }
__device__ __forceinline__ unsigned xb_xcc_id() { return (unsigned)__builtin_amdgcn_s_getreg((3 << 11) | 20) & 0xFu; }
#define XB_SPIN(cond, bar) do { unsigned _sp = 0; while (cond) { __builtin_amdgcn_s_sleep(1); \
    if ((++_sp & 255u) == 0u) { if (xb_ld(&(bar)[XB_TMO])) break; if (_sp > XB_SPIN_CAP) { atomicAdd(&(bar)[XB_TMO], 1u); break; } } } } while (0)

struct XcdBarrier {
    unsigned* bar; unsigned x;
    volatile LAS unsigned* st;
};

__device__ __forceinline__ XcdBarrier xcd_barrier_post(unsigned* bar, volatile LAS unsigned* st) {
    XcdBarrier b; b.bar = bar; b.x = xb_xcc_id(); b.st = st;
    if (threadIdx.x == 0) (void)xb_add(&bar[XB_XCNT(b.x)], 1u);
    return b;
}
__device__ __forceinline__ void xcd_barrier_complete(unsigned* bar, unsigned x, unsigned& nloc, unsigned& nx) {
    const unsigned G = gridDim.x * gridDim.y * gridDim.z;
    unsigned sum, cnt, mine, sp = 0u;
    for (;;) {
        sum = 0u; cnt = 0u; mine = 0u;
#pragma unroll
        for (unsigned j = 0; j < 16; ++j) { const unsigned c = xb_ld(&bar[XB_XCNT(j)]); sum += c; cnt += (c > 0u) ? 1u : 0u; mine = (j == x) ? c : mine; }
        if (sum == G) break;
        __builtin_amdgcn_s_sleep(1);
        if ((++sp & 255u) == 0u) { if (xb_ld(&bar[XB_TMO])) break; if (sp > XB_SPIN_CAP) { atomicAdd(&bar[XB_TMO], 1u); break; } }
    }
    nloc = mine > 0u ? mine : 1u; nx = cnt > 0u ? cnt : 1u;
}

__device__ __forceinline__ void xcd_barrier(const XcdBarrier& b) {
    asm volatile("s_waitcnt vmcnt(0)" ::: "memory");
    __syncthreads();
    if (threadIdx.x == 0) {
        unsigned* bar = b.bar;
        __builtin_amdgcn_s_waitcnt(0);
        unsigned nloc = b.st[0], nx = b.st[1];
        if (nloc == 0u) { xcd_barrier_complete(bar, b.x, nloc, nx); b.st[0] = nloc; b.st[1] = nx; }
        const unsigned old = xb_add(&bar[XB_XSUB(b.x)], 1u);
        const unsigned gen = old / nloc;
        if (old + 1u == (gen + 1u) * nloc) {
            __builtin_amdgcn_fence(__ATOMIC_RELEASE, "agent");
            asm volatile("s_waitcnt vmcnt(0)" ::: "memory");
            const unsigned og = xb_add(&bar[XB_TOP], 1u);
            const unsigned tg = og / nx;
            if (og + 1u == (tg + 1u) * nx) xb_add(&bar[XB_TOPGEN], 1u);
            else XB_SPIN(xb_ld(&bar[XB_TOPGEN]) == tg, bar);
            __builtin_amdgcn_fence(__ATOMIC_ACQUIRE, "agent");
            xb_add(&bar[XB_XGEN(b.x)], 1u);
            asm volatile("s_waitcnt vmcnt(0)" ::: "memory");
        } else {
            XB_SPIN(xb_ld(&bar[XB_XGEN(b.x)]) == gen, bar);
            __builtin_amdgcn_fence(__ATOMIC_ACQUIRE, "agent");
            asm volatile("s_waitcnt vmcnt(0)" ::: "memory");
        }
    }
    __syncthreads();
}


constexpr int FX_CNT_WORD = 16384;
struct RowStats {
    float* slots;
    unsigned* cnt;
    __device__ __forceinline__ void run(const pg8::f32x4 (&v)[2][2][4][2], const pg8::Unit& u, int wr, int wc, int fr, int fq, LAS unsigned char* lds, int wid, int lane, const float* rprev) const {
        LAS float* P = (LAS float*)lds;
        LAS float* S = (LAS float*)(lds + 8192);
#pragma unroll
        for (int ai = 0; ai < 2; ++ai)
#pragma unroll
            for (int mm = 0; mm < 4; ++mm) {
                float s = 0.f;
#pragma unroll
                for (int bj = 0; bj < 2; ++bj)
#pragma unroll
                    for (int n = 0; n < 2; ++n) { const pg8::f32x4 x = v[ai][bj][mm][n]; s += (x[0] * x[0] + x[1] * x[1]) + (x[2] * x[2] + x[3] * x[3]); }
                s += __shfl_xor(s, 16); s += __shfl_xor(s, 32);
                if (fq == 0) P[(ai * 128 + wr * 64 + mm * 16 + fr) * 4 + wc] = s;
            }
        asm volatile("s_waitcnt lgkmcnt(0)" ::: "memory"); __builtin_amdgcn_s_barrier(); asm volatile("" ::: "memory");
        const int row = wid * 32 + (lane & 31);
        const float pr = rprev[u.pm * 256 + row];
        if (lane < 32) {
            const float t = (P[row * 4 + 0] + P[row * 4 + 1]) + (P[row * 4 + 2] + P[row * 4 + 3]);
            __hip_atomic_store(slots + ((size_t)(u.pm * 256 + row) * 4 + u.pn), t, __ATOMIC_RELAXED, __HIP_MEMORY_SCOPE_AGENT);
        }
        asm volatile("s_waitcnt vmcnt(0)" ::: "memory");
        if (lane == 0) __hip_atomic_fetch_add(cnt + 64 * u.pm, 1u, __ATOMIC_RELAXED, __HIP_MEMORY_SCOPE_AGENT);
        if (wid == 0) { unsigned sp = 0;
            while ((unsigned)__builtin_amdgcn_readfirstlane(__hip_atomic_load(cnt + 64 * u.pm, __ATOMIC_RELAXED, __HIP_MEMORY_SCOPE_AGENT)) < 32u && ++sp < (1u << 22)) __builtin_amdgcn_s_sleep(1); }
        asm volatile("s_waitcnt vmcnt(0) lgkmcnt(0)" ::: "memory"); __builtin_amdgcn_s_barrier(); asm volatile("" ::: "memory");
        if (lane < 32) {
            const float* sl = slots + (size_t)(u.pm * 256 + row) * 4; float t = 0.f;
#pragma unroll
            for (int k = 0; k < 4; ++k) t += __hip_atomic_load(sl + k, __ATOMIC_RELAXED, __HIP_MEMORY_SCOPE_AGENT);
            const float p2 = pr * pr; S[row] = t * (1.f / DM) + EPS * __builtin_amdgcn_rcpf(p2 * p2);
        }
        asm volatile("s_waitcnt vmcnt(0) lgkmcnt(0)" ::: "memory"); __builtin_amdgcn_s_barrier(); asm volatile("" ::: "memory");
    }
};
struct EpiRmsRes {
    static constexpr bool PERM = true, AFTER_DRAIN = true;
    const void* xin; void* xout; const float* gpost; float* rsout; RowStats st1, st2; int xin32, last; const float* rsprev; const float* ones;
    __device__ __forceinline__ void fused(pg8::f32x4 (&acc)[2][2][4][2], const pg8::Unit& u, int wr, int wc, int fr, int fq, LAS unsigned char* lds, int wid, int lane) const {
        const LAS float* S = (const LAS float*)(lds + 8192);
        const int col0 = u.pn * 256 + wc * 64 + 8 * fq;
        u32x4 xpre[2][4][2];
        if (!xin32) {
#pragma unroll
            for (int ai = 0; ai < 2; ++ai)
#pragma unroll
                for (int mm = 0; mm < 4; ++mm) { const size_t off = (size_t)(u.pm * 256 + ai * 128 + wr * 64 + mm * 16 + fr) * DM + col0;
#pragma unroll
                    for (int bj = 0; bj < 2; ++bj) xpre[ai][mm][bj] = *(const u32x4*)((const bf16*)xin + off + bj * 32); }
        }
        st1.run(acc, u, wr, wc, fr, fq, lds, wid, lane, rsprev);
        pg8::f32x4 gv[2][2];
#pragma unroll
        for (int bj = 0; bj < 2; ++bj)
#pragma unroll
            for (int n = 0; n < 2; ++n) gv[bj][n] = *(const pg8::f32x4*)(gpost + col0 + bj * 32 + n * 4);
#pragma unroll
        for (int ai = 0; ai < 2; ++ai)
#pragma unroll
            for (int mm = 0; mm < 4; ++mm) {
                const int r = ai * 128 + wr * 64 + mm * 16 + fr; const float rs = __builtin_amdgcn_rsqf(S[r]);
                const size_t off = (size_t)(u.pm * 256 + r) * DM + col0;
#pragma unroll
                for (int bj = 0; bj < 2; ++bj) {
                    pg8::f32x4 xa, xb;
                    if (xin32) { xa = *(const pg8::f32x4*)((const float*)xin + off + bj * 32); xb = *(const pg8::f32x4*)((const float*)xin + off + bj * 32 + 4); }
                    else { const u32x4 w = xpre[ai][mm][bj]; xa = (pg8::f32x4){bflo(w.x), bfhi(w.x), bflo(w.y), bfhi(w.y)}; xb = (pg8::f32x4){bflo(w.z), bfhi(w.z), bflo(w.w), bfhi(w.w)}; }
                    const pg8::f32x4 ya = xa + acc[ai][bj][mm][0] * rs * gv[bj][0], yb = xb + acc[ai][bj][mm][1] * rs * gv[bj][1];
                    acc[ai][bj][mm][0] = ya; acc[ai][bj][mm][1] = yb;
                    if (last) { *(pg8::f32x4*)((float*)xout + off + bj * 32) = ya; *(pg8::f32x4*)((float*)xout + off + bj * 32 + 4) = yb; }
                    else { u32x4 w; w.x = pk2(ya[0], ya[1]); w.y = pk2(ya[2], ya[3]); w.z = pk2(yb[0], yb[1]); w.w = pk2(yb[2], yb[3]); *(u32x4*)((bf16*)xout + off + bj * 32) = w; }
                }
                if (mm & 1) asm volatile("" ::: "memory");
            }
        if (!last) {
            st2.run(acc, u, wr, wc, fr, fq, lds, wid, lane, ones);
            if (u.pn == 0 && wc == 0 && fq == 0) {
#pragma unroll
                for (int ai = 0; ai < 2; ++ai)
#pragma unroll
                    for (int mm = 0; mm < 4; ++mm) { const int r = ai * 128 + wr * 64 + mm * 16 + fr; rsout[u.pm * 256 + r] = __builtin_amdgcn_rsqf(S[r]); }
            }
        }
        asm volatile("s_waitcnt lgkmcnt(0)" ::: "memory"); __builtin_amdgcn_s_barrier(); asm volatile("" ::: "memory");
    }
};
struct OneUnit {
    pg8::StaticOrder base; int round;
    __device__ __forceinline__ bool next(int i, pg8::Unit& u) const { return i == 0 && base.next(round, u); }
    __device__ __forceinline__ void a_ready(const pg8::Unit&) const {}
    __device__ __forceinline__ void done(const pg8::Unit&) const {}
};

#ifndef REP_SYNC
#define REP_SYNC 1
#endif
#define GSYNC() do { for (int rs_ = 0; rs_ < REP_SYNC; ++rs_) xcd_barrier(xbar); } while (0)
struct Args { const float* in[16]; float* out; unsigned char* ws; };

__global__ void __launch_bounds__(NWAVES * 64, 2) mega_fwd(Args args) {
    extern __shared__ __attribute__((aligned(16))) unsigned char lds_raw[];
    cg::grid_group grid = cg::this_grid();
    LAS unsigned char* lds = (LAS unsigned char*)lds_raw;
    const int tid = threadIdx.x, lane = tid & 63, wave = __builtin_amdgcn_readfirstlane(tid >> 6);
    const int G = gridDim.x, bx = blockIdx.x;
    const int gw = bx * NWAVES + wave, NGW = G * NWAVES;
    unsigned char* ws = args.ws;
    const float* x_in = args.in[0];
    float* xres = args.out;
    bf16* Hb = (bf16*)(ws + WS_H); bf16* MB = (bf16*)(ws + WS_MB); bf16* XR = (bf16*)(ws + WS_XR); float* LSE = (float*)(ws + WS_LSE);
    float* RS1 = (float*)(ws + WS_RS1); float* RS2 = (float*)(ws + WS_RS2); float* RS0 = (float*)(ws + WS_RS1 + 524288);
    bf16* Zb = (bf16*)(ws + WS_Z); bf16* MIX = (bf16*)(ws + WS_MIX); bf16* AB = (bf16*)(ws + WS_A);

    unsigned* barw = (unsigned*)(ws + WS_CTL);
    if (bx == 0) for (int i = tid; i < XCD_BAR_WORDS; i += NWAVES * 64) __hip_atomic_store(barw + i, 0u, __ATOMIC_RELAXED, __HIP_MEMORY_SCOPE_AGENT);
    if (tid < 2) ((volatile LAS unsigned*)(lds + XB_LDS_OFF))[tid] = 0u;
    for (int i = bx * (NWAVES * 64) + tid; i < 16 * 128 * 64; i += G * NWAVES * 64) __hip_atomic_store(barw + FX_CNT_WORD + i, 0u, __ATOMIC_RELAXED, __HIP_MEMORY_SCOPE_AGENT);
#ifndef REP_P0
#define REP_P0 1
#endif
    for (int rep_ = 0; rep_ < REP_P0; ++rep_) {
        LAS float* scr = (LAS float*)(lds + wave * 16384);
        constexpr int I_IN = (DM / 64) * (INW / 32), I_OUT = (DM / 64) * (DM / 32), I_F1 = (DM / 64) * (DFF / 32), I_F2 = (DFF / 64) * (DM / 32);
        constexpr int I_LAYER = I_IN + I_OUT + I_F1 + I_F2;
        for (int it = gw; it < DEPTH * I_LAYER; it += NGW) {
            const int l = it / I_LAYER; int r = it % I_LAYER;
            if (r < I_IN) { p0_transpose_item(args.in[5] + (size_t)l * DM * INW, DM, INW, (bf16*)(ws + WS_WIN) + (size_t)l * INW * DM, scr, r, lane, args.in[1] + l * DM); continue; } r -= I_IN;
            if (r < I_OUT) { p0_transpose_item(args.in[13] + (size_t)l * DM * DM, DM, DM, (bf16*)(ws + WS_WOUT) + (size_t)l * DM * DM, scr, r, lane, nullptr); continue; } r -= I_OUT;
            if (r < I_F1) { p0_transpose_item(args.in[14] + (size_t)l * DM * DFF, DM, DFF, (bf16*)(ws + WS_WFF1) + (size_t)l * DFF * DM, scr, r, lane, args.in[3] + l * DM); continue; } r -= I_F1;
            p0_transpose_item(args.in[15] + (size_t)l * DFF * DM, DFF, DM, (bf16*)(ws + WS_WFF2) + (size_t)l * DM * DFF, scr, r, lane, nullptr);
        }
        for (int i = bx * (NWAVES * 64) + tid; i < M; i += G * NWAVES * 64) RS0[i] = 1.0f;
        if (M % (4 * NGW) == 0) { for (int m = gw; m < M; m += 4 * NGW) rms_rows_to_bf16<4>(x_in, RS1, XR, m, NGW, lane); }
        else { for (int m = gw; m < M; m += NGW) rms_rows_to_bf16<1>(x_in, RS1, XR, m, NGW, lane); }
    }
    __syncthreads();
    grid.sync();
    XcdBarrier xbar = xcd_barrier_post(barw, (volatile LAS unsigned*)(lds + XB_LDS_OFF));

#ifdef PROBE_IDLE
    if (1) { const unsigned long long t0 = __builtin_amdgcn_s_memrealtime(); while (__builtin_amdgcn_s_memrealtime() - t0 < 50000ull) __builtin_amdgcn_s_sleep(64); }
#endif
    for (int l = 0; l < DEPTH; ++l) {
        {
            pg8::Gemm g{XR, (const bf16*)(ws + WS_WIN) + (size_t)l * INW * DM, M, INW, DM}; pg8::StaticOrder S; S.init(M, INW, G, bx);
            pg8::EpiBf16<0> E{Zb, INW, nullptr, AW, (size_t)AW, QSCALE, RS1, lds + XEPI_LDS_OFF, 0};
            pg8::gemm_phase<pg8::EpiBf16<0>, pg8::StaticOrder, PG8_ALIGN, PG8_SP2>(lds, g, S, E);
        }
        GSYNC();
#ifndef REP_MIX
#define REP_MIX 1
#endif
        for (int rep_ = 0; rep_ < REP_MIX; ++rep_) {
#ifndef REP_LRU
#define REP_LRU 1
#endif
            for (int rl_ = 0; rl_ < REP_LRU; ++rl_)
            for (int u0 = bx; u0 < NB * 8 * 4; u0 += G) { const int u = ((G & 7) == 0 && G == NB * 8 * 4) ? (u0 & 7) * (G >> 3) + (u0 >> 3) : u0;
                lru_unit(u, Zb, MIX, args.in[6] + (size_t)l * 4 * LW, args.in[7] + (size_t)l * LW, args.in[8] + (size_t)l * 8 * 64 * 64, args.in[9] + (size_t)l * LW,
                         args.in[10] + (size_t)l * 8 * 64 * 64, args.in[11] + (size_t)l * LW, args.in[12] + (size_t)l * LW, lds); }
            AttPre P = {};
#define ATT_UIDX(k) (((((k) * (G >> 3) + (bx >> 3)) / 48) * 8 + (bx & 7)) * 48 + (((k) * (G >> 3) + (bx >> 3)) % 48))
            const int nk = ((G & 7) == 0 && ATT_UNITS % G == 0) ? ATT_UNITS / G : 0;
            int u = nk ? ATT_UIDX(0) : bx;
            if (u < ATT_UNITS) att_issue(u, Zb, P);
            for (int k = 0; u < ATT_UNITS; ++k) {
                const int unext = nk ? ((k + 1 < nk) ? ATT_UIDX(k + 1) : ATT_UNITS) : u + G;
                __syncthreads();
                att_stage(P, lds);
                const u32x4 qa0 = P.q[0], qa1 = P.q[1], qb0 = P.q[2], qb1 = P.q[3];
                __syncthreads();
                if (unext < ATT_UNITS) att_issue(unext, Zb, P);
                att_compute(u, 0, qa0, qa1, ws, LSE, lds);
                att_compute(u, 1, qb0, qb1, ws, LSE, lds);
                u = unext;
            }
#undef ATT_UIDX
        }
        GSYNC();
#ifndef REP_CMB
#define REP_CMB 1
#endif
        for (int rc_ = 0; rc_ < REP_CMB; ++rc_) { int t_ = threadIdx.x; asm volatile("" : "+v"(t_)); att_combine(ws, LSE, MIX, bx * (NWAVES * 64) + t_, G * NWAVES * 64); }
        GSYNC();
        for (int rnd = 0; rnd < 2; ++rnd) {
            pg8::Gemm g{MIX, (const bf16*)(ws + WS_WOUT) + (size_t)l * DM * DM, M, DM, DM}; OneUnit S; S.base.init(M, DM, G, bx); S.round = rnd;
            unsigned* cb = barw + FX_CNT_WORD + ((l * 2 + 0) * 2) * 128 * 64;
            EpiRmsRes E{(l == 0) ? (const void*)x_in : (const void*)XR, (void*)XR, args.in[2] + l * DM, RS2, RowStats{(float*)(ws + WS_FX1), cb}, RowStats{(float*)(ws + WS_FX2), cb + 128 * 64}, (l == 0) ? 1 : 0, 0, (const float*)RS0, (const float*)RS0};
            pg8::gemm_phase<EpiRmsRes, OneUnit, false, PG8_SP2>(lds, g, S, E);
        }
        GSYNC();
#ifndef REP_G3
#define REP_G3 1
#endif
        for (int rep_ = 0; rep_ < REP_G3; ++rep_) {
            pg8::Gemm g{XR, (const bf16*)(ws + WS_WFF1) + (size_t)l * DFF * DM, M, DFF, DM}; pg8::StaticOrder S; S.init(M, DFF, G, bx);
            pg8::EpiBf16<2> E{AB, DFF, nullptr, 0, 0, 1.f, nullptr, lds + XEPI_LDS_OFF, 1};
            pg8::gemm_phase<pg8::EpiBf16<2>, pg8::StaticOrder, PG8_ALIGN, PG8_SP2>(lds, g, S, E);
        }
        GSYNC();
        for (int rnd = 0; rnd < 2; ++rnd) {
            pg8::Gemm g{AB, (const bf16*)(ws + WS_WFF2) + (size_t)l * DM * DFF, M, DM, DFF}; OneUnit S; S.base.init(M, DM, G, bx); S.round = rnd;
            unsigned* cb = barw + FX_CNT_WORD + ((l * 2 + 1) * 2) * 128 * 64;
            const int lastl = (l + 1 == DEPTH) ? 1 : 0;
            EpiRmsRes E{(const void*)XR, lastl ? (void*)xres : (void*)XR, args.in[4] + l * DM, RS1, RowStats{(float*)(ws + WS_FX1), cb}, RowStats{(float*)(ws + WS_FX2), cb + 128 * 64}, 0, lastl, (const float*)RS2, (const float*)RS0};
            pg8::gemm_phase<EpiRmsRes, OneUnit, false, PG8_SP2, true>(lds, g, S, E);
        }
        if (l + 1 < DEPTH) GSYNC();
    }
}

extern "C" void kernel_launch(void* const* d_in, const int* in_sizes, int n_in, void* d_out, int out_size, void* d_ws, size_t ws_size, hipStream_t stream) {
    static int grid = 0;
    if (grid == 0) {
        if (n_in != 16 || in_sizes[0] != M * DM || out_size != M * DM || ws_size < WS_END) { fprintf(stderr, "kernel_launch: unexpected shapes (n_in %d, in0 %d, out %d, ws %zu); nothing launched\n", n_in, n_in > 0 ? in_sizes[0] : -1, out_size, ws_size); grid = -1; return; }
        int dev = 0, cus = 0, per_cu = 0;
        if (hipGetDevice(&dev) != hipSuccess || hipDeviceGetAttribute(&cus, hipDeviceAttributeMultiprocessorCount, dev) != hipSuccess) { grid = -1; return; }
        if (hipFuncSetAttribute((const void*)mega_fwd, hipFuncAttributeMaxDynamicSharedMemorySize, LDS_BYTES) != hipSuccess) { fprintf(stderr, "kernel_launch: hipFuncSetAttribute failed\n"); grid = -1; return; }
        if (hipOccupancyMaxActiveBlocksPerMultiprocessor(&per_cu, (const void*)mega_fwd, NWAVES * 64, LDS_BYTES) != hipSuccess || per_cu < 1) { fprintf(stderr, "kernel_launch: occupancy query says %d\n", per_cu); per_cu = 1; }
        (void)hipGetLastError();
        grid = cus * per_cu;
    }
    if (grid < 0) return;
    Args a{};
    for (int i = 0; i < 16; ++i) a.in[i] = (const float*)d_in[i];
    a.out = (float*)d_out; a.ws = (unsigned char*)d_ws;
    void* kargs[] = {&a};
    hipError_t e = hipLaunchCooperativeKernel((const void*)mega_fwd, dim3(grid), dim3(NWAVES * 64), kargs, LDS_BYTES, stream);
    if (e != hipSuccess) fprintf(stderr, "kernel_launch: cooperative launch failed: %s (grid %d)\n", hipGetErrorString(e), grid);
}
```
